# Optimizing an MI355X kernel written in HIP

```python
import jax, jax.numpy as jnp
from jax import lax
import numpy as np

D_MODEL = 1024
BATCH = 8
SEQ = 4096
DEPTH = 1

PLE_DIM = 256
D_FF = 2816
LRU_WIDTH = 1024
LRU_BLOCKS = 8
LRU_BLOCK_W = LRU_WIDTH // LRU_BLOCKS
CONV_WIDTH = 4
LRU_C = 8.0
MLA_HEADS = 8
QK_NOPE = 128
QK_ROPE = 64
V_HEAD = 128
Q_LORA = 384
KV_LORA = 256
ROPE_THETA = 10000.0
Q_BLOCK = 128
EPS = 1e-6
IN_SPLITS = (LRU_WIDTH, LRU_WIDTH, Q_LORA, KV_LORA, QK_ROPE, D_MODEL, D_MODEL)
IN_COLS = sum(IN_SPLITS)

kernel_name = "hybrid_rglru_mla_macaron_block"


def rmsnorm(x, g):
    xf = x.astype(jnp.float32)
    y = xf * lax.rsqrt(jnp.mean(xf * xf, axis=-1, keepdims=True) + EPS)
    return (y * g.astype(jnp.float32)).astype(x.dtype)


def swiglu(x, w_gate, w_up, w_down):
    return (jax.nn.silu(x @ w_gate) * (x @ w_up)) @ w_down


def centred_depthwise_conv(x, w, b):
    s = x.shape[1]
    left = CONV_WIDTH // 2
    xp = jnp.pad(x, ((0, 0), (left, CONV_WIDTH - 1 - left), (0, 0)))
    y = b
    for k in range(CONV_WIDTH):
        y = y + xp[:, k:k + s, :] * w[k]
    return y


def _linear_recurrence_combine(left, right):
    a_l, b_l = left
    a_r, b_r = right
    return a_l * a_r, a_r * b_l + b_r


def rg_lru(x, w_r, b_r, w_i, b_i, lam, reverse):
    bsz, s, c = x.shape
    xb = x.reshape(bsz, s, LRU_BLOCKS, LRU_BLOCK_W)
    r = jax.nn.sigmoid(jnp.einsum('bsnc,ncd->bsnd', xb, w_r).reshape(bsz, s, c) + b_r)
    gi = jax.nn.sigmoid(jnp.einsum('bsnc,ncd->bsnd', xb, w_i).reshape(bsz, s, c) + b_i)
    log_a = -LRU_C * r.astype(jnp.float32) * jax.nn.softplus(-lam.astype(jnp.float32))
    a = jnp.exp(log_a)
    u = jnp.sqrt(-jnp.expm1(2.0 * log_a)) * (gi * x).astype(jnp.float32)
    _, h = lax.associative_scan(_linear_recurrence_combine, (a, u), reverse=reverse, axis=1)
    return h.astype(x.dtype)


def rope_cos_sin(positions, dim, dtype):
    inv_freq = ROPE_THETA ** (-jnp.arange(0, dim, 2, dtype=jnp.float32) / dim)
    ang = positions.astype(jnp.float32)[..., None] * inv_freq
    return (jnp.cos(ang)[:, :, None, :].astype(dtype), jnp.sin(ang)[:, :, None, :].astype(dtype))


def apply_rope(x, cos, sin):
    x1, x2 = jnp.split(x, 2, axis=-1)
    return jnp.concatenate([x1 * cos - x2 * sin, x2 * cos + x1 * sin], axis=-1)


def mla(c_q, c_kv, k_rope, positions, q_norm, w_uq, kv_norm, w_ukv):
    bsz, s, _ = c_q.shape
    cos, sin = rope_cos_sin(positions, QK_ROPE, c_q.dtype)
    q = (rmsnorm(c_q, q_norm) @ w_uq).reshape(bsz, s, MLA_HEADS, QK_NOPE + QK_ROPE)
    q = jnp.concatenate([q[..., :QK_NOPE], apply_rope(q[..., QK_NOPE:], cos, sin)], axis=-1)
    kv = (rmsnorm(c_kv, kv_norm) @ w_ukv).reshape(bsz, s, MLA_HEADS, QK_NOPE + V_HEAD)
    k_pe = jnp.broadcast_to(apply_rope(k_rope[:, :, None, :], cos, sin), (bsz, s, MLA_HEADS, QK_ROPE))
    k = jnp.concatenate([kv[..., :QK_NOPE], k_pe], axis=-1)
    v = kv[..., QK_NOPE:]
    scale = (QK_NOPE + QK_ROPE) ** -0.5
    n_blk = s // Q_BLOCK
    q_blocks = q.reshape(bsz, n_blk, Q_BLOCK, MLA_HEADS, QK_NOPE + QK_ROPE).transpose(1, 0, 2, 3, 4)

    def attend(qb):
        sc = jnp.einsum('bqhd,bkhd->bhqk', qb, k).astype(jnp.float32) * scale
        pr = jax.nn.softmax(sc, axis=-1).astype(v.dtype)
        return jnp.einsum('bhqk,bkhd->bqhd', pr, v)

    o = lax.map(attend, q_blocks)
    return o.transpose(1, 0, 2, 3, 4).reshape(bsz, s, MLA_HEADS * V_HEAD)


def _dense(k, shape, fan_in):
    return jax.random.normal(k, shape, jnp.float32) * (fan_in ** -0.5)


def _gain(k, shape):
    return 1.0 + 0.05 * jax.random.normal(k, shape, jnp.float32)


def _bias(k, shape):
    return 0.01 * jax.random.normal(k, shape, jnp.float32)


def setup_inputs(seed: int = 0) -> dict:
    key = jax.random.key(seed)
    ks = jax.random.split(key, 32)
    L = DEPTH
    a_init = jax.random.uniform(ks[15], (L, 2, LRU_WIDTH), jnp.float32, 0.9, 0.999) ** (1.0 / LRU_C)
    lru_lambda = jnp.log(a_init) - jnp.log1p(-a_init)
    return {
        "x": jax.random.normal(ks[0], (BATCH, SEQ, D_MODEL), jnp.float32),
        "p": jax.random.normal(ks[1], (L, BATCH, SEQ, PLE_DIM), jnp.float32),
        "positions": jnp.broadcast_to(jnp.arange(SEQ, dtype=jnp.int32), (BATCH, SEQ)),
        "ffn1_norm": _gain(ks[2], (L, D_MODEL)),
        "ffn1_w_gate": _dense(ks[3], (L, D_MODEL, D_FF), D_MODEL),
        "ffn1_w_up": _dense(ks[4], (L, D_MODEL, D_FF), D_MODEL),
        "ffn1_w_down": _dense(ks[5], (L, D_FF, D_MODEL), D_FF),
        "mix_norm": _gain(ks[6], (L, D_MODEL)),
        "w_in": _dense(ks[7], (L, D_MODEL, IN_COLS), D_MODEL),
        "conv_w": _dense(ks[8], (L, CONV_WIDTH, LRU_WIDTH), CONV_WIDTH),
        "conv_b": _bias(ks[9], (L, LRU_WIDTH)),
        "lru_w_r": _dense(ks[10], (L, 2, LRU_BLOCKS, LRU_BLOCK_W, LRU_BLOCK_W), LRU_BLOCK_W),
        "lru_b_r": _bias(ks[11], (L, 2, LRU_WIDTH)),
        "lru_w_i": _dense(ks[12], (L, 2, LRU_BLOCKS, LRU_BLOCK_W, LRU_BLOCK_W), LRU_BLOCK_W),
        "lru_b_i": _bias(ks[13], (L, 2, LRU_WIDTH)),
        "lru_lambda": lru_lambda,
        "w_lru_out": _dense(ks[14], (L, LRU_WIDTH, D_MODEL), LRU_WIDTH),
        "q_norm": _gain(ks[16], (L, Q_LORA)),
        "w_uq": _dense(ks[17], (L, Q_LORA, MLA_HEADS * (QK_NOPE + QK_ROPE)), Q_LORA),
        "kv_norm": _gain(ks[18], (L, KV_LORA)),
        "w_ukv": _dense(ks[19], (L, KV_LORA, MLA_HEADS * (QK_NOPE + V_HEAD)), KV_LORA),
        "w_mla_out": _dense(ks[20], (L, MLA_HEADS * V_HEAD, D_MODEL), MLA_HEADS * V_HEAD),
        "w_o": _dense(ks[21], (L, D_MODEL, D_MODEL), D_MODEL),
        "ffn2_norm": _gain(ks[22], (L, D_MODEL)),
        "ffn2_w_gate": _dense(ks[23], (L, D_MODEL, D_FF), D_MODEL),
        "ffn2_w_up": _dense(ks[24], (L, D_MODEL, D_FF), D_MODEL),
        "ffn2_w_down": _dense(ks[25], (L, D_FF, D_MODEL), D_FF),
        "ple_norm": _gain(ks[26], (L, D_MODEL)),
        "ple_w_gate": _dense(ks[27], (L, D_MODEL, D_MODEL), D_MODEL),
        "ple_w_proj": _dense(ks[28], (L, PLE_DIM, D_MODEL), PLE_DIM),
        "ple_proj_norm": _gain(ks[29], (L, D_MODEL)),
        "final_norm": _gain(ks[30], (D_MODEL,)),
    }


def reference(x, p, positions, ffn1_norm, ffn1_w_gate, ffn1_w_up, ffn1_w_down, mix_norm, w_in,
              conv_w, conv_b, lru_w_r, lru_b_r, lru_w_i, lru_b_i, lru_lambda, w_lru_out,
              q_norm, w_uq, kv_norm, w_ukv, w_mla_out, w_o, ffn2_norm, ffn2_w_gate, ffn2_w_up,
              ffn2_w_down, ple_norm, ple_w_gate, ple_w_proj, ple_proj_norm, final_norm):
    split_at = np.cumsum(IN_SPLITS)[:-1].tolist()
    h = x
    for i in range(DEPTH):
        h = h + 0.5 * swiglu(rmsnorm(h, ffn1_norm[i]), ffn1_w_gate[i], ffn1_w_up[i], ffn1_w_down[i])
        u = rmsnorm(h, mix_norm[i])
        z_x, z_g, c_q, c_kv, k_rope, gate_a, gate_b = jnp.split(u @ w_in[i], split_at, axis=-1)
        xa = centred_depthwise_conv(z_x, conv_w[i], conv_b[i])
        ya = (rg_lru(xa, lru_w_r[i, 0], lru_b_r[i, 0], lru_w_i[i, 0], lru_b_i[i, 0], lru_lambda[i, 0], False)
              + rg_lru(xa, lru_w_r[i, 1], lru_b_r[i, 1], lru_w_i[i, 1], lru_b_i[i, 1], lru_lambda[i, 1], True))
        ya = (ya * jax.nn.gelu(z_g)) @ w_lru_out[i]
        yb = mla(c_q, c_kv, k_rope, positions, q_norm[i], w_uq[i], kv_norm[i], w_ukv[i]) @ w_mla_out[i]
        merged = jax.nn.sigmoid(gate_a) * ya + jax.nn.sigmoid(gate_b) * yb
        h = h + merged @ w_o[i]
        h = h + 0.5 * swiglu(rmsnorm(h, ffn2_norm[i]), ffn2_w_gate[i], ffn2_w_up[i], ffn2_w_down[i])
        ple_gate = jax.nn.sigmoid(rmsnorm(h, ple_norm[i]) @ ple_w_gate[i])
        h = h + ple_gate * rmsnorm(p[i] @ ple_w_proj[i], ple_proj_norm[i])
    return rmsnorm(h, final_norm)
```

```cpp
#include <hip/hip_runtime.h>
#include <hip/hip_cooperative_groups.h>
#include <cstdio>
#include <cmath>
namespace cg = cooperative_groups;
#ifndef MK_ONE_LAUNCH
#define MK_ONE_LAUNCH 1
#endif
namespace pg8 {
#define PG8_LAS __attribute__((address_space(3)))
typedef unsigned short bf16_t;
typedef short bf16x8 __attribute__((ext_vector_type(8)));
typedef float f32x4 __attribute__((ext_vector_type(4)));
typedef unsigned u32x4 __attribute__((ext_vector_type(4)));
constexpr int BM = 256, BK = 64, HALF = 128, HTB = HALF * BK * 2  , STAGE_BYTES = 8 * HTB, NXCD = 8, WGM = 8;

__host__ __device__ __forceinline__ int lds_byte(int r, int c) { const int st = (r >> 4) * 2 + (c >> 5), rr = r & 15, cc = c & 31, ob = rr * 64 + cc * 2; return st * 1024 + (ob ^ (((ob >> 9) & 1) << 5)); }
__host__ __device__ __forceinline__ void stage_rc(int b, int& R, int& C) { const int st = b / 1024, sb = b % 1024, swz = sb ^ (((sb >> 9) & 1) << 5); R = (st >> 1) * 16 + swz / 64; C = (st & 1) * 32 + (swz % 64) / 2; }
__host__ __device__ __forceinline__ int perm32(int rho) { const int n = rho >> 4, i = rho & 15; return 8 * (i >> 2) + 4 * n + (i & 3); }

struct Unit { int pm, pn; };
struct Gemm { const bf16_t* A; const bf16_t* Bt; int M, N, K; };

struct StaticOrder {
    int nM, nN, nwg, G, c;
    __host__ __device__ void init(int M, int N, int G_, int c_) { nM = M / BM; nN = N / BM; nwg = nM * nN; G = G_; c = c_; }
    __host__ __device__ bool next(int i, Unit& u) const {
        const long L = (long)i * G + c; if (L >= nwg) return false;
        int wgid = (int)L; { const int q = nwg / NXCD, r = nwg % NXCD, xcd = wgid % NXCD, off = wgid / NXCD; wgid = (xcd < r ? xcd * (q + 1) : r * (q + 1) + (xcd - r) * q) + off; }
        const int nig = WGM * nN, gid = wgid / nig, fm = gid * WGM, gsz = (nM - fm) < WGM ? (nM - fm) : WGM;
        u.pm = fm + ((wgid % nig) % gsz); u.pn = (wgid % nig) / gsz; return true;
    }
    __device__ __forceinline__ void a_ready(const Unit&) const {}
    __device__ __forceinline__ void done(const Unit&) const {}
};
typedef float cvt_f32x2 __attribute__((ext_vector_type(2)));
typedef __bf16 cvt_bf16x2 __attribute__((ext_vector_type(2)));
__device__ __forceinline__ unsigned cvt_pk_bf16(float lo, float hi) { const cvt_f32x2 v = {lo, hi}; const cvt_bf16x2 r = __builtin_convertvector(v, cvt_bf16x2); return __builtin_bit_cast(unsigned, r); }
typedef float f32x2 __attribute__((ext_vector_type(2)));
template <class Epi, class Sched, bool STAMP = false>
__device__ __forceinline__ void gemm_phase(PG8_LAS unsigned char* lds, const Gemm g, const Sched& S, const Epi& E, unsigned long long* stamps) {
    int tid_ = threadIdx.x; asm volatile("" : "+v"(tid_));
    const int tid = tid_, wid = __builtin_amdgcn_readfirstlane(tid >> 6), lane = tid & 63, wr = wid >> 2, wc = wid & 3, fr = lane & 15, fq = lane >> 4;
    const int K = g.K, nt = K / BK;
    int ts_lo = 0, ts_hi = 0, nts = 0; const unsigned long long rt_entry = STAMP ? (unsigned long long)wall_clock64() : 0ull;
#define PG8_STAMP() do { if (STAMP && wid == 0 && nts < 64) { const unsigned long long _c = (unsigned long long)clock64(); \
        ts_lo = (lane == nts) ? (int)(unsigned)_c : ts_lo; ts_hi = (lane == nts) ? (int)(unsigned)(_c >> 32) : ts_hi; ++nts; } } while (0)
    PG8_STAMP();
    unsigned voffA[2], voffB[2];
#pragma unroll
    for (int i = 0; i < 2; ++i) { int R, C; stage_rc(tid * 16 + i * 8192, R, C); const int Rb = Epi::PERM ? ((R & ~31) + perm32(R & 31)) : R;
        voffA[i] = (unsigned)(R * K + C) * 2u; voffB[i] = (unsigned)(Rb * K + C) * 2u; }
    const size_t kstep = (size_t)(BK * 2);
    const size_t hstep = (size_t)HALF * K * 2;
    const size_t tstep = 2 * hstep;
    const unsigned ldsw = (unsigned)wid * 1024u;
    const int aoff = lds_byte(wr * 64 + fr, fq * 8), boff = lds_byte(wc * 32 + fr, fq * 8);
#define PG8_SA(b, h) (((b) * 2 + (h)) * HTB)
#define PG8_SB(b, h) ((4 + (b) * 2 + (h)) * HTB)
#define PG8_STAGE(bufoff, gbase, voff) do { _Pragma("unroll") for (int _i = 0; _i < 2; ++_i) \
        __builtin_amdgcn_global_load_lds((const unsigned*)((const char*)(gbase) + (voff)[_i]), (PG8_LAS unsigned*)(lds + (bufoff) + ldsw + _i * 8192), 16, 0, 0); } while (0)
#define PG8_LDA(dst, b, h) do { _Pragma("unroll") for (int m = 0; m < 4; ++m) _Pragma("unroll") for (int k = 0; k < 2; ++k) dst[m][k] = *(const PG8_LAS bf16x8*)(lds + PG8_SA(b, h) + aoff + m * 2048 + k * 1024); } while (0)
#define PG8_LDB(dst, b, h) do { _Pragma("unroll") for (int n = 0; n < 2; ++n) _Pragma("unroll") for (int k = 0; k < 2; ++k) dst[n][k] = *(const PG8_LAS bf16x8*)(lds + PG8_SB(b, h) + boff + n * 2048 + k * 1024); } while (0)
#define PG8_MMA(ai, bj, At, Bt) do { __builtin_amdgcn_s_setprio(1); _Pragma("unroll") for (int m = 0; m < 4; ++m) _Pragma("unroll") for (int n = 0; n < 2; ++n) _Pragma("unroll") for (int k = 0; k < 2; ++k) \
        acc[ai][bj][m][n] = __builtin_amdgcn_mfma_f32_16x16x32_bf16(Bt[n][k], At[m][k], acc[ai][bj][m][n], 0, 0, 0); __builtin_amdgcn_s_setprio(0); } while (0)
#define PG8_WAIT_V(n) asm volatile("s_waitcnt vmcnt(" #n ")" ::: "memory")
#define PG8_WAIT_L(n) asm volatile("s_waitcnt lgkmcnt(" #n ")" ::: "memory")
#define PG8_BAR __builtin_amdgcn_s_barrier()
#define PG8_SCHED __builtin_amdgcn_sched_barrier(0)
    Unit cur, nxt; int ui = 0;
    if (!S.next(0, cur)) return;
    f32x4 acc[2][2][4][2];
#pragma unroll
    for (int a = 0; a < 2; ++a)
#pragma unroll
        for (int b = 0; b < 2; ++b)
#pragma unroll
            for (int m = 0; m < 4; ++m)
#pragma unroll
                for (int n = 0; n < 2; ++n) acc[a][b][m][n] = (f32x4){0.f, 0.f, 0.f, 0.f};
    bf16x8 At[4][2], B0[2][2], B1[2][2];
    const char* cA = (const char*)g.A + (size_t)cur.pm * tstep; const char* cB = (const char*)g.Bt + (size_t)cur.pn * tstep;
    S.a_ready(cur);
    PG8_STAGE(PG8_SB(0, 0), cB, voffB); PG8_STAGE(PG8_SA(0, 0), cA, voffA); PG8_STAGE(PG8_SB(0, 1), cB + hstep, voffB); PG8_STAGE(PG8_SA(0, 1), cA + hstep, voffA);
    if (wr == 1) PG8_BAR;
    PG8_WAIT_V(4); PG8_BAR;
    PG8_STAGE(PG8_SB(1, 0), cB + kstep, voffB); PG8_STAGE(PG8_SA(1, 0), cA + kstep, voffA); PG8_STAGE(PG8_SB(1, 1), cB + hstep + kstep, voffB);
    PG8_WAIT_V(6); PG8_BAR;
    PG8_STAMP();
    for (;;) {
        const bool has_next = S.next(ui + 1, nxt);
        const char* nA = has_next ? (const char*)g.A + (size_t)nxt.pm * tstep : cA; const char* nB = has_next ? (const char*)g.Bt + (size_t)nxt.pn * tstep : cB;
        for (int t = 0; t < nt; t += 2) {
            const bool last = (t == nt - 2);
            const char* a1 = cA + (size_t)(t + 1) * kstep;
            const char* a2 = last ? nA : cA + (size_t)(t + 2) * kstep; const char* b2 = last ? nB : cB + (size_t)(t + 2) * kstep;
            const char* a3 = a2 + kstep; const char* b3 = b2 + kstep;
            if (last && has_next) S.a_ready(nxt);
            PG8_LDB(B0, 0, 0); PG8_SCHED; PG8_LDA(At, 0, 0); PG8_STAGE(PG8_SA(1, 1), a1 + hstep, voffA);
            PG8_WAIT_L(8); PG8_BAR; PG8_WAIT_L(0); PG8_MMA(0, 0, At, B0); PG8_BAR; PG8_SCHED;
            PG8_LDB(B1, 0, 1); PG8_STAGE(PG8_SB(0, 0), b2, voffB);
            PG8_BAR; PG8_WAIT_L(0); PG8_MMA(0, 1, At, B1); PG8_BAR;
            PG8_LDA(At, 0, 1); PG8_STAGE(PG8_SA(0, 0), a2, voffA);
            PG8_BAR; PG8_WAIT_L(0); PG8_MMA(1, 0, At, B0); PG8_BAR; PG8_SCHED;
            PG8_STAGE(PG8_SB(0, 1), b2 + hstep, voffB);
            PG8_WAIT_V(6); PG8_BAR; PG8_MMA(1, 1, At, B1); PG8_BAR;
            PG8_LDB(B0, 1, 0); PG8_SCHED; PG8_LDA(At, 1, 0); PG8_STAGE(PG8_SA(0, 1), a2 + hstep, voffA);
            PG8_WAIT_L(8); PG8_BAR; PG8_WAIT_L(0); PG8_MMA(0, 0, At, B0); PG8_BAR; PG8_SCHED;
            PG8_LDB(B1, 1, 1); PG8_STAGE(PG8_SB(1, 0), b3, voffB);
            PG8_BAR; PG8_WAIT_L(0); PG8_MMA(0, 1, At, B1); PG8_BAR;
            PG8_LDA(At, 1, 1); PG8_STAGE(PG8_SA(1, 0), a3, voffA);
            PG8_BAR; PG8_WAIT_L(0); PG8_MMA(1, 0, At, B0); PG8_BAR; PG8_SCHED;
            PG8_STAGE(PG8_SB(1, 1), b3 + hstep, voffB);
            PG8_WAIT_V(6); PG8_BAR; PG8_MMA(1, 1, At, B1); PG8_BAR;
        }
        PG8_STAMP();
        if constexpr (!Epi::AFTER_DRAIN) { E(acc, cur, wr, wc, fr, fq); S.done(cur); }
        PG8_STAMP();
        if (!has_next) break;
#pragma unroll
        for (int a = 0; a < 2; ++a)
#pragma unroll
            for (int b = 0; b < 2; ++b)
#pragma unroll
                for (int m = 0; m < 4; ++m)
#pragma unroll
                    for (int n = 0; n < 2; ++n) acc[a][b][m][n] = (f32x4){0.f, 0.f, 0.f, 0.f};
        cur = nxt; cA = nA; cB = nB; ++ui;
    }
    PG8_WAIT_V(0);
    if (wr == 0) PG8_BAR;
    PG8_BAR;
    if constexpr (Epi::AFTER_DRAIN) { E.fused(acc, cur, wr, wc, fr, fq, lds, wid, lane); S.done(cur); }
    PG8_STAMP();
    if (STAMP && wid == 0) { stamps[lane] = lane < nts ? (((unsigned long long)(unsigned)ts_hi << 32) | (unsigned)ts_lo) : 0ull;
        if (lane == 62) stamps[62] = rt_entry; if (lane == 63) stamps[63] = (unsigned long long)wall_clock64(); }
#undef PG8_STAMP
#undef PG8_SA
#undef PG8_SB
#undef PG8_STAGE
#undef PG8_LDA
#undef PG8_LDB
#undef PG8_MMA
#undef PG8_WAIT_V
#undef PG8_WAIT_L
#undef PG8_BAR
#undef PG8_SCHED
}
}

#define LAS __attribute__((address_space(3)))
typedef unsigned short bf16_t;
typedef short bf16x8 __attribute__((ext_vector_type(8)));
typedef short s16x4 __attribute__((ext_vector_type(4)));
typedef float f32x4 __attribute__((ext_vector_type(4)));
typedef float f32x16 __attribute__((ext_vector_type(16)));
typedef unsigned u32x4 __attribute__((ext_vector_type(4)));
typedef unsigned u32x2 __attribute__((ext_vector_type(2)));
using pg8::cvt_pk_bf16;

constexpr int MT = 32768, SEQ = 4096, DM = 1024, DFF = 2816;
constexpr float EPS = 1e-6f;
constexpr size_t UU = 67108864ull;
constexpr size_t EW1GU = 0, EW1D = 5767168, EWIN = 8650752, EWG = 13631488, EWUQ = 14155776, EWUKV = 14745600, EWLO = 15269888,
                 EWMO = 16318464, EWO = 17367040, EW2GU = 18415616, EW2D = 24182784, EWPG = 27066368, EWPP = 28114944;
constexpr size_t OFF_INVF = 55ull << 20;
constexpr size_t OFF_BAR = (55ull << 20) + (512ull << 10);
constexpr size_t OFF_CARP = 56ull << 20, OFF_CARH = 60ull << 20;
constexpr size_t OFF_A = UU, OFF_B = 2 * UU, OFF_C = 3 * UU, OFF_D = 4 * UU, OFF_E = 5 * UU, OFF_F = 6 * UU, OFF_G = 6 * UU + UU / 2, OFF_H = 6 * UU + 3 * UU / 4;
constexpr size_t OFF_CQN = OFF_H, OFF_CKVN = OFF_CQN + 3 * UU / 8, OFF_KPE = OFF_CKVN + UU / 4, OFF_QR = OFF_KPE + UU / 16;
constexpr size_t WS_NEED = 8 * UU;
static_assert(OFF_QR + UU / 2 <= WS_NEED, "workspace map");
constexpr int LDS_BYTES = 152576;
constexpr int NPHASE = 18;

struct Params {
    const float *x, *p; const int* pos;
    const float *ffn1_norm, *ffn1_wg, *ffn1_wu, *ffn1_wd, *mix_norm, *w_in, *conv_w, *conv_b, *lru_wr, *lru_br, *lru_wi, *lru_bi, *lru_lam, *w_lru_out,
        *q_norm, *w_uq, *kv_norm, *w_ukv, *w_mla_out, *w_o, *ffn2_norm, *ffn2_wg, *ffn2_wu, *ffn2_wd, *ple_norm, *ple_wg, *ple_wp, *ple_pn, *final_norm;
    float* out; unsigned char* ws;
    float inv_freq[32];
};

__device__ __forceinline__ float bflo(unsigned w) { return __uint_as_float(w << 16); }
__device__ __forceinline__ float bfhi(unsigned w) { return __uint_as_float(w & 0xffff0000u); }
__device__ __forceinline__ float bf2f(bf16_t b) { return __uint_as_float(((unsigned)b) << 16); }
__device__ __forceinline__ bf16_t f2bf(float f) { return (bf16_t)(cvt_pk_bf16(f, f) & 0xffffu); }
__device__ __forceinline__ float fsigmoid(float x) { return __builtin_amdgcn_rcpf(1.0f + __expf(-x)); }
__device__ __forceinline__ float fsilu(float x) { return x * fsigmoid(x); }
__device__ __forceinline__ float fgelu_tanh(float x) { return x * fsigmoid(1.5957691216057308f * (x + 0.044715f * x * x * x)); }
__device__ __forceinline__ float wave_sum(float v, int lane) {
#pragma unroll
    for (int o = 32; o >= 1; o >>= 1) v += __uint_as_float((unsigned)__builtin_amdgcn_ds_bpermute((lane ^ o) << 2, (int)__float_as_uint(v)));
    return v;
}
__device__ __forceinline__ void rope_cs(float ang, float& c, float& s) {
    const float k = rintf(ang * 0.15915494309189535f);
    float r = fmaf(-k, 6.28318548202514648f, ang); r = fmaf(-k, -1.74845553e-07f, r);
    const float rev = r * 0.15915494309189535f;
    s = __builtin_amdgcn_sinf(rev); c = __builtin_amdgcn_cosf(rev);
}
__device__ __forceinline__ u32x4 pack8(const float (&e)[8]) { u32x4 w; w.x = cvt_pk_bf16(e[0], e[1]); w.y = cvt_pk_bf16(e[2], e[3]); w.z = cvt_pk_bf16(e[4], e[5]); w.w = cvt_pk_bf16(e[6], e[7]); return w; }
__device__ __forceinline__ void unpack8(u32x4 w, float (&e)[8]) { e[0] = bflo(w.x); e[1] = bfhi(w.x); e[2] = bflo(w.y); e[3] = bfhi(w.y); e[4] = bflo(w.z); e[5] = bfhi(w.z); e[6] = bflo(w.w); e[7] = bfhi(w.w); }

struct WtCtx { LAS float* tile; int gw, nw, lane, base; };
__device__ __forceinline__ void wt_job(WtCtx& c, const float* __restrict__ src, int K, int ldn, int n0, int ncols, bf16_t* __restrict__ dst, int ldd, int drow0, int grp, int gstride) {
    const int tk = K >> 6, tn = ncols >> 5, nt = tk * tn;
    int t = c.gw - c.base; if (t < 0) t += c.nw;
    const int rr = c.lane >> 3, c4 = (c.lane & 7) << 2, ks = c.lane & 7, nn = c.lane >> 3;
    for (; t < nt; t += c.nw) {
        const int nti = t % tn, kti = t / tn, k0 = kti << 6, j0 = nti << 5;
        float4 v[8];
#pragma unroll
        for (int i = 0; i < 8; ++i) v[i] = *(const float4*)(src + (size_t)(k0 + rr + 8 * i) * ldn + n0 + j0 + c4);
#pragma unroll
        for (int i = 0; i < 8; ++i) { LAS float* q = c.tile + (rr + 8 * i) * 33 + c4; q[0] = v[i].x; q[1] = v[i].y; q[2] = v[i].z; q[3] = v[i].w; }
        asm volatile("s_waitcnt lgkmcnt(0)" ::: "memory");
#pragma unroll
        for (int ps = 0; ps < 4; ++ps) {
            const int n = ps * 8 + nn;
            float e[8];
#pragma unroll
            for (int i = 0; i < 8; ++i) e[i] = c.tile[(ks * 8 + i) * 33 + n];
            const int j = j0 + n, drow = drow0 + (j / grp) * gstride + (j % grp);
            *(u32x4*)(dst + (size_t)drow * ldd + k0 + ks * 8) = pack8(e);
        }
        asm volatile("s_waitcnt lgkmcnt(0)" ::: "memory");
    }
    c.base = (c.base + nt) % c.nw;
}

__device__ __forceinline__ void norm_rows(const float* in, const float* __restrict__ g, bf16_t* __restrict__ out, int gw, int nw, int lane) {
    float4 gv[4];
#pragma unroll
    for (int i = 0; i < 4; ++i) gv[i] = ((const float4*)g)[lane + 64 * i];
    for (int row = gw; row < MT; row += nw) {
        const float4* p = (const float4*)(in + (size_t)row * DM);
        float4 v[4];
#pragma unroll
        for (int i = 0; i < 4; ++i) v[i] = p[lane + 64 * i];
        float ss = 0.f;
#pragma unroll
        for (int i = 0; i < 4; ++i) ss += v[i].x * v[i].x + v[i].y * v[i].y + v[i].z * v[i].z + v[i].w * v[i].w;
        ss = wave_sum(ss, lane);
        const float rs = rsqrtf(ss * (1.0f / 1024.0f) + EPS);
#pragma unroll
        for (int i = 0; i < 4; ++i) {
            u32x2 w; w.x = cvt_pk_bf16(v[i].x * rs * gv[i].x, v[i].y * rs * gv[i].y); w.y = cvt_pk_bf16(v[i].z * rs * gv[i].z, v[i].w * rs * gv[i].w);
            *(u32x2*)(out + (size_t)row * DM + 4 * (lane + 64 * i)) = w;
        }
    }
}

__device__ __forceinline__ void mid_rows(const Params& p, int gw, int nw, int lane) {
    const bf16_t* cqkr = (const bf16_t*)(p.ws + OFF_F); const bf16_t* ckv = (const bf16_t*)(p.ws + OFF_G);
    bf16_t* cqn = (bf16_t*)(p.ws + OFF_CQN); bf16_t* ckvn = (bf16_t*)(p.ws + OFF_CKVN); bf16_t* kpe = (bf16_t*)(p.ws + OFF_KPE);
    const float* invf = (const float*)(p.ws + OFF_INVF);
    float2 gq[3], gk[2];
#pragma unroll
    for (int i = 0; i < 3; ++i) gq[i] = ((const float2*)p.q_norm)[lane + 64 * i];
#pragma unroll
    for (int i = 0; i < 2; ++i) gk[i] = ((const float2*)p.kv_norm)[lane + 64 * i];
    const float fi = invf[lane & 31];
    for (int row = gw; row < MT; row += nw) {
        const unsigned* q32 = (const unsigned*)(cqkr + (size_t)row * 512);
        const unsigned* k32 = (const unsigned*)(ckv + (size_t)row * 256);
        unsigned a[3], b[2];
#pragma unroll
        for (int i = 0; i < 3; ++i) a[i] = q32[lane + 64 * i];
#pragma unroll
        for (int i = 0; i < 2; ++i) b[i] = k32[lane + 64 * i];
        const float x1 = bf2f(cqkr[(size_t)row * 512 + 384 + (lane & 31)]), x2 = bf2f(cqkr[(size_t)row * 512 + 416 + (lane & 31)]);
        const float posf = (float)p.pos[row];
        float sq = 0.f, sk = 0.f;
#pragma unroll
        for (int i = 0; i < 3; ++i) { const float lo = bflo(a[i]), hi = bfhi(a[i]); sq += lo * lo + hi * hi; }
#pragma unroll
        for (int i = 0; i < 2; ++i) { const float lo = bflo(b[i]), hi = bfhi(b[i]); sk += lo * lo + hi * hi; }
        sq = wave_sum(sq, lane); sk = wave_sum(sk, lane);
        const float rq = rsqrtf(sq * (1.0f / 384.0f) + EPS), rk = rsqrtf(sk * (1.0f / 256.0f) + EPS);
        unsigned* oq = (unsigned*)(cqn + (size_t)row * 384); unsigned* ok = (unsigned*)(ckvn + (size_t)row * 256);
#pragma unroll
        for (int i = 0; i < 3; ++i) oq[lane + 64 * i] = cvt_pk_bf16(bflo(a[i]) * rq * gq[i].x, bfhi(a[i]) * rq * gq[i].y);
#pragma unroll
        for (int i = 0; i < 2; ++i) ok[lane + 64 * i] = cvt_pk_bf16(bflo(b[i]) * rk * gk[i].x, bfhi(b[i]) * rk * gk[i].y);
        float cs, sn; rope_cs(posf * fi, cs, sn);
        if (lane < 32) { kpe[(size_t)row * 64 + lane] = f2bf(x1 * cs - x2 * sn); kpe[(size_t)row * 64 + 32 + lane] = f2bf(x2 * cs + x1 * sn); }
    }
}

__device__ __forceinline__ void final_rows(const Params& p, int gw, int nw, int lane) {
    const float* gate = (const float*)(p.ws + OFF_B); const float* pp = (const float*)(p.ws + OFF_D);
    float4 g1[4], g2[4];
#pragma unroll
    for (int i = 0; i < 4; ++i) { g1[i] = ((const float4*)p.ple_pn)[lane + 64 * i]; g2[i] = ((const float4*)p.final_norm)[lane + 64 * i]; }
    for (int row = gw; row < MT; row += nw) {
        float4* ph = (float4*)(p.out + (size_t)row * DM);
        const float4* pg = (const float4*)(gate + (size_t)row * DM); const float4* pq = (const float4*)(pp + (size_t)row * DM);
        float4 h[4], g[4], q[4];
#pragma unroll
        for (int i = 0; i < 4; ++i) { h[i] = ph[lane + 64 * i]; g[i] = pg[lane + 64 * i]; q[i] = pq[lane + 64 * i]; }
        float s1 = 0.f;
#pragma unroll
        for (int i = 0; i < 4; ++i) s1 += q[i].x * q[i].x + q[i].y * q[i].y + q[i].z * q[i].z + q[i].w * q[i].w;
        s1 = wave_sum(s1, lane);
        const float r1 = rsqrtf(s1 * (1.0f / 1024.0f) + EPS);
        float s2 = 0.f;
#pragma unroll
        for (int i = 0; i < 4; ++i) {
            h[i].x += g[i].x * (q[i].x * r1 * g1[i].x); h[i].y += g[i].y * (q[i].y * r1 * g1[i].y); h[i].z += g[i].z * (q[i].z * r1 * g1[i].z); h[i].w += g[i].w * (q[i].w * r1 * g1[i].w);
            s2 += h[i].x * h[i].x + h[i].y * h[i].y + h[i].z * h[i].z + h[i].w * h[i].w;
        }
        s2 = wave_sum(s2, lane);
        const float r2 = rsqrtf(s2 * (1.0f / 1024.0f) + EPS);
#pragma unroll
        for (int i = 0; i < 4; ++i) { float4 o; o.x = h[i].x * r2 * g2[i].x; o.y = h[i].y * r2 * g2[i].y; o.z = h[i].z * r2 * g2[i].z; o.w = h[i].w * r2 * g2[i].w; ph[lane + 64 * i] = o; }
    }
}

template <int ACT> __device__ __forceinline__ void store_bf16_tile(const f32x4 (&acc)[2][2][4][2], bf16_t* O, int ld, int row0, int col0) {
#pragma unroll
    for (int ai = 0; ai < 2; ++ai)
#pragma unroll
        for (int m = 0; m < 4; ++m) {
            bf16_t* rowp = O + (size_t)(row0 + ai * 128 + m * 16) * ld + col0;
#pragma unroll
            for (int bj = 0; bj < 2; ++bj) {
                float e[8];
#pragma unroll
                for (int j = 0; j < 4; ++j) { e[j] = acc[ai][bj][m][0][j]; e[4 + j] = acc[ai][bj][m][1][j]; }
                if (ACT == 1) {
#pragma unroll
                    for (int j = 0; j < 8; ++j) e[j] = fgelu_tanh(e[j]);
                }
                if (ACT == 2) {
#pragma unroll
                    for (int j = 0; j < 8; ++j) e[j] = fsigmoid(e[j]);
                }
                *(u32x4*)(rowp + bj * 128) = pack8(e);
            }
        }
}
struct EpiSwiGLU {
    static constexpr bool PERM = true, AFTER_DRAIN = false; bf16_t* O;
    __device__ __forceinline__ void operator()(const f32x4 (&acc)[2][2][4][2], const pg8::Unit& u, int wr, int wc, int fr, int fq) const {
        const int row0 = u.pm * 256 + wr * 64 + fr, col0 = u.pn * 128 + wc * 32 + 8 * fq;
#pragma unroll
        for (int ai = 0; ai < 2; ++ai)
#pragma unroll
            for (int m = 0; m < 4; ++m) {
                float e[8];
#pragma unroll
                for (int j = 0; j < 4; ++j) { e[j] = fsilu(acc[ai][0][m][0][j]) * acc[ai][1][m][0][j]; e[4 + j] = fsilu(acc[ai][0][m][1][j]) * acc[ai][1][m][1][j]; }
                *(u32x4*)(O + (size_t)(row0 + ai * 128 + m * 16) * DFF + col0) = pack8(e);
            }
    }
};
struct EpiResid {
    static constexpr bool PERM = false, AFTER_DRAIN = false; const float* base; float* out; float alpha;
    __device__ __forceinline__ void operator()(const f32x4 (&acc)[2][2][4][2], const pg8::Unit& u, int wr, int wc, int fr, int fq) const {
        const int row0 = u.pm * 256 + wr * 64 + fr, col0 = u.pn * 256 + wc * 32 + 4 * fq;
#pragma unroll
        for (int ai = 0; ai < 2; ++ai)
#pragma unroll
            for (int m = 0; m < 4; ++m) {
                const size_t off = (size_t)(row0 + ai * 128 + m * 16) * DM + col0;
#pragma unroll
                for (int bj = 0; bj < 2; ++bj)
#pragma unroll
                    for (int n = 0; n < 2; ++n) { const f32x4 b = *(const f32x4*)(base + off + bj * 128 + n * 16); *(f32x4*)(out + off + bj * 128 + n * 16) = b + alpha * acc[ai][bj][m][n]; }
            }
    }
};
template <int ACT> struct EpiF32Act {
    static constexpr bool PERM = false, AFTER_DRAIN = false; float* out;
    __device__ __forceinline__ void operator()(const f32x4 (&acc)[2][2][4][2], const pg8::Unit& u, int wr, int wc, int fr, int fq) const {
        const int row0 = u.pm * 256 + wr * 64 + fr, col0 = u.pn * 256 + wc * 32 + 4 * fq;
#pragma unroll
        for (int ai = 0; ai < 2; ++ai)
#pragma unroll
            for (int m = 0; m < 4; ++m) {
                const size_t off = (size_t)(row0 + ai * 128 + m * 16) * DM + col0;
#pragma unroll
                for (int bj = 0; bj < 2; ++bj)
#pragma unroll
                    for (int n = 0; n < 2; ++n) { f32x4 v = acc[ai][bj][m][n];
                        if (ACT == 1) { v[0] = fsigmoid(v[0]); v[1] = fsigmoid(v[1]); v[2] = fsigmoid(v[2]); v[3] = fsigmoid(v[3]); }
                        *(f32x4*)(out + off + bj * 128 + n * 16) = v; }
            }
    }
};
struct EpiWin {
    static constexpr bool PERM = true, AFTER_DRAIN = false; unsigned char* ws;
    __device__ __forceinline__ void operator()(const f32x4 (&acc)[2][2][4][2], const pg8::Unit& u, int wr, int wc, int fr, int fq) const {
        const int pn = u.pn, row0 = u.pm * 256 + wr * 64 + fr, cw = wc * 32 + 8 * fq;
        if (pn < 4) store_bf16_tile<0>(acc, (bf16_t*)(ws + OFF_B), 1024, row0, 256 * pn + cw);
        else if (pn < 8) store_bf16_tile<1>(acc, (bf16_t*)(ws + OFF_C), 1024, row0, 256 * (pn - 4) + cw);
        else if (pn < 11) { bf16_t* O = (bf16_t*)(ws + (pn == 8 ? OFF_G : OFF_F)); const int ld = pn == 8 ? 256 : 512, c0 = pn == 8 ? 0 : 256 * (pn - 9); store_bf16_tile<0>(acc, O, ld, row0, c0 + cw); }
        else { bf16_t* O = (bf16_t*)(ws + (pn < 15 ? OFF_D : OFF_E)); const int c0 = 256 * (pn < 15 ? pn - 11 : pn - 15); store_bf16_tile<2>(acc, O, 1024, row0, c0 + cw); }
    }
};
struct EpiGateMul {
    static constexpr bool PERM = true, AFTER_DRAIN = false; const bf16_t* G; const bf16_t* T; bf16_t* O; int add;
    __device__ __forceinline__ void operator()(const f32x4 (&acc)[2][2][4][2], const pg8::Unit& u, int wr, int wc, int fr, int fq) const {
        const int row0 = u.pm * 256 + wr * 64 + fr, col0 = u.pn * 256 + wc * 32 + 8 * fq;
#pragma unroll
        for (int ai = 0; ai < 2; ++ai)
#pragma unroll
            for (int m = 0; m < 4; ++m) {
                const size_t off = (size_t)(row0 + ai * 128 + m * 16) * DM + col0;
#pragma unroll
                for (int bj = 0; bj < 2; ++bj) {
                    float g[8], e[8]; unpack8(*(const u32x4*)(G + off + bj * 128), g);
#pragma unroll
                    for (int j = 0; j < 4; ++j) { e[j] = g[j] * acc[ai][bj][m][0][j]; e[4 + j] = g[4 + j] * acc[ai][bj][m][1][j]; }
                    if (add) { float t[8]; unpack8(*(const u32x4*)(T + off + bj * 128), t);
#pragma unroll
                        for (int j = 0; j < 8; ++j) e[j] += t[j]; }
                    *(u32x4*)(O + off + bj * 128) = pack8(e);
                }
            }
    }
};
struct EpiQ {
    static constexpr bool PERM = true, AFTER_DRAIN = false; bf16_t* Qn; bf16_t* Qr;
    __device__ __forceinline__ void operator()(const f32x4 (&acc)[2][2][4][2], const pg8::Unit& u, int wr, int wc, int fr, int fq) const {
        const int row0 = u.pm * 256 + wr * 64 + fr;
        if (u.pn < 4) { store_bf16_tile<0>(acc, Qn, 1024, row0, 256 * u.pn + wc * 32 + 8 * fq); return; }
        const int head = 4 * (u.pn - 4) + wc;
#pragma unroll
        for (int ai = 0; ai < 2; ++ai)
#pragma unroll
            for (int m = 0; m < 4; ++m) {
                bf16_t* dst = Qr + (size_t)(row0 + ai * 128 + m * 16) * 512 + 64 * head + 8 * fq;
                float e[8];
#pragma unroll
                for (int j = 0; j < 4; ++j) { e[j] = acc[ai][0][m][0][j]; e[4 + j] = acc[ai][0][m][1][j]; }
                *(u32x4*)dst = pack8(e);
#pragma unroll
                for (int j = 0; j < 4; ++j) { e[j] = acc[ai][1][m][0][j]; e[4 + j] = acc[ai][1][m][1][j]; }
                *(u32x4*)(dst + 32) = pack8(e);
            }
    }
};
struct EpiKV {
    static constexpr bool PERM = true, AFTER_DRAIN = false; bf16_t* Kn; bf16_t* V;
    __device__ __forceinline__ void operator()(const f32x4 (&acc)[2][2][4][2], const pg8::Unit& u, int wr, int wc, int fr, int fq) const {
        const int row0 = u.pm * 256 + wr * 64 + fr, col0 = u.pn * 128 + wc * 32 + 8 * fq;
#pragma unroll
        for (int ai = 0; ai < 2; ++ai)
#pragma unroll
            for (int m = 0; m < 4; ++m) {
                const size_t off = (size_t)(row0 + ai * 128 + m * 16) * DM + col0;
                float e[8];
#pragma unroll
                for (int j = 0; j < 4; ++j) { e[j] = acc[ai][0][m][0][j]; e[4 + j] = acc[ai][0][m][1][j]; }
                *(u32x4*)(Kn + off) = pack8(e);
#pragma unroll
                for (int j = 0; j < 4; ++j) { e[j] = acc[ai][1][m][0][j]; e[4 + j] = acc[ai][1][m][1][j]; }
                *(u32x4*)(V + off) = pack8(e);
            }
    }
};

constexpr int LRU_XS = 272;
constexpr int LRU_AP = 132;
template <bool FINAL>
__device__ __forceinline__ void lru_phase(const Params& p, LAS unsigned char* lds, int bid, int G) {
    int tid_ = threadIdx.x; asm volatile("" : "+v"(tid_));
    const int tid = tid_, wid = tid >> 6, lane = tid & 63, fr = lane & 15, fq = lane >> 4;
    LAS unsigned char* Xs = lds;
    LAS float* AF = (LAS float*)(lds + 64 * LRU_XS);
    LAS float* UF = AF + 64 * LRU_AP; LAS float* AB = UF + 64 * LRU_AP; LAS float* UB = AB + 64 * LRU_AP;
    const bf16_t* zx = (const bf16_t*)(p.ws + OFF_B); const bf16_t* zg = (const bf16_t*)(p.ws + OFF_C); bf16_t* yA = (bf16_t*)(p.ws + OFF_A);
    float* carP = (float*)(p.ws + OFF_CARP); float* carH = (float*)(p.ws + OFF_CARH);
    const bf16_t* WG = (const bf16_t*)p.ws + EWG;
    for (int item = bid; item < 4096; item += G) {
        const int blk = item & 7, c = (item >> 3) & 63, b = item >> 9;
        const int t0 = c * 64; const size_t rowbase = (size_t)b * SEQ;
        bf16x8 Bf[4][4];
        { const bf16_t* wb = WG + (size_t)blk * 65536 + (size_t)(wid * 16 + fr) * 128 + fq * 8;
#pragma unroll
          for (int g = 0; g < 4; ++g)
#pragma unroll
              for (int ks = 0; ks < 4; ++ks) Bf[g][ks] = *(const bf16x8*)(wb + (size_t)g * 16384 + ks * 32); }
        { const int tok = tid >> 3, cs = tid & 7, cg0 = blk * 128 + cs * 16;
          float y[16];
#pragma unroll
          for (int q = 0; q < 4; ++q) { const float4 bv = *(const float4*)(p.conv_b + cg0 + 4 * q); y[4 * q] = bv.x; y[4 * q + 1] = bv.y; y[4 * q + 2] = bv.z; y[4 * q + 3] = bv.w; }
#pragma unroll
          for (int k = 0; k < 4; ++k) {
              const int t = t0 + tok + k - 2;
              if (t >= 0 && t < SEQ) {
                  const u32x4* zp = (const u32x4*)(zx + (rowbase + t) * DM + cg0);
                  float z[16]; { float e[8]; unpack8(zp[0], e);
#pragma unroll
                      for (int j = 0; j < 8; ++j) z[j] = e[j];
                      unpack8(zp[1], e);
#pragma unroll
                      for (int j = 0; j < 8; ++j) z[8 + j] = e[j]; }
#pragma unroll
                  for (int q = 0; q < 4; ++q) { const float4 wv = *(const float4*)(p.conv_w + k * 1024 + cg0 + 4 * q);
                      y[4 * q] += wv.x * z[4 * q]; y[4 * q + 1] += wv.y * z[4 * q + 1]; y[4 * q + 2] += wv.z * z[4 * q + 2]; y[4 * q + 3] += wv.w * z[4 * q + 3]; }
              }
          }
          float e0[8], e1[8];
#pragma unroll
          for (int j = 0; j < 8; ++j) { e0[j] = y[j]; e1[j] = y[8 + j]; }
          LAS u32x4* xd = (LAS u32x4*)(Xs + tok * LRU_XS + cs * 32);
          xd[0] = pack8(e0); xd[1] = pack8(e1);
        }
        __syncthreads();
        { const int ch = wid * 16 + fr, cg = blk * 128 + ch;
          const float brf = p.lru_br[cg], bif = p.lru_bi[cg], brb = p.lru_br[1024 + cg], bib = p.lru_bi[1024 + cg];
          const float spf = 8.0f * log1pf(expf(-p.lru_lam[cg])), spb = 8.0f * log1pf(expf(-p.lru_lam[1024 + cg]));
#pragma unroll
          for (int m = 0; m < 4; ++m) {
              bf16x8 Af[4];
#pragma unroll
              for (int ks = 0; ks < 4; ++ks) Af[ks] = *(const LAS bf16x8*)(Xs + (16 * m + fr) * LRU_XS + (ks * 32 + fq * 8) * 2);
              f32x4 acc[4];
#pragma unroll
              for (int g = 0; g < 4; ++g) { acc[g] = (f32x4){0.f, 0.f, 0.f, 0.f};
#pragma unroll
                  for (int ks = 0; ks < 4; ++ks) acc[g] = __builtin_amdgcn_mfma_f32_16x16x32_bf16(Af[ks], Bf[g][ks], acc[g], 0, 0, 0); }
#pragma unroll
              for (int j = 0; j < 4; ++j) {
                  const int tok = 16 * m + 4 * fq + j;
                  const float x = bf2f(*(const LAS bf16_t*)(Xs + tok * LRU_XS + ch * 2));
#pragma unroll
                  for (int d = 0; d < 2; ++d) {
                      const float r = fsigmoid(acc[2 * d][j] + (d ? brb : brf)), gi = fsigmoid(acc[2 * d + 1][j] + (d ? bib : bif));
                      const float la = -r * (d ? spb : spf);
                      const float a = __expf(la);
                      const float e2 = 2.0f * la;
                      const float om = (e2 > -0.125f) ? -e2 * (1.0f + e2 * (0.5f + e2 * (0.16666667f + e2 * (0.041666668f + e2 * 0.0083333338f)))) : 1.0f - __expf(e2);
                      const float uu = sqrtf(om) * (gi * x);
                      (d ? AB : AF)[tok * LRU_AP + ch] = a; (d ? UB : UF)[tok * LRU_AP + ch] = uu;
                  }
              }
          }
        }
        __syncthreads();
        if (tid < 256) {
            const int dir = tid >> 7, ch = tid & 127, cgl = blk * 128 + ch;
            LAS float* Aa = dir ? AB : AF; LAS float* Uu = dir ? UB : UF;
            const size_t cb = ((size_t)(b * 2 + dir) * 64) * 1024 + cgl;
            float h = 0.f, P = 1.f;
            if (FINAL) {
                if (dir == 0) { for (int c2 = 0; c2 < c; ++c2) h = carP[cb + (size_t)c2 * 1024] * h + carH[cb + (size_t)c2 * 1024]; }
                else { for (int c2 = 63; c2 > c; --c2) h = carP[cb + (size_t)c2 * 1024] * h + carH[cb + (size_t)c2 * 1024]; }
            }
            if (dir == 0) {
#pragma unroll 8
                for (int t = 0; t < 64; ++t) { const float a = Aa[t * LRU_AP + ch], uu = Uu[t * LRU_AP + ch]; h = a * h + uu; if (FINAL) Uu[t * LRU_AP + ch] = h; else P *= a; }
            } else {
#pragma unroll 8
                for (int t = 63; t >= 0; --t) { const float a = Aa[t * LRU_AP + ch], uu = Uu[t * LRU_AP + ch]; h = a * h + uu; if (FINAL) Uu[t * LRU_AP + ch] = h; else P *= a; }
            }
            if (!FINAL) { carP[cb + (size_t)c * 1024] = P; carH[cb + (size_t)c * 1024] = h; }
        }
        if (FINAL) {
            __syncthreads();
            const int tok = tid >> 3, cs = tid & 7, cg0 = blk * 128 + cs * 16; const size_t row = rowbase + t0 + tok;
            const u32x4* gp = (const u32x4*)(zg + row * DM + cg0);
            u32x4* yp = (u32x4*)(yA + row * DM + cg0);
#pragma unroll
            for (int hh = 0; hh < 2; ++hh) {
                float g[8], e[8]; unpack8(gp[hh], g);
                const f32x4 f0 = *(const LAS f32x4*)(UF + tok * LRU_AP + cs * 16 + hh * 8), f1 = *(const LAS f32x4*)(UF + tok * LRU_AP + cs * 16 + hh * 8 + 4);
                const f32x4 b0 = *(const LAS f32x4*)(UB + tok * LRU_AP + cs * 16 + hh * 8), b1 = *(const LAS f32x4*)(UB + tok * LRU_AP + cs * 16 + hh * 8 + 4);
#pragma unroll
                for (int j = 0; j < 4; ++j) { e[j] = (f0[j] + b0[j]) * g[j]; e[4 + j] = (f1[j] + b1[j]) * g[4 + j]; }
                yp[hh] = pack8(e);
            }
        }
    }
    __syncthreads();
}

namespace att {
constexpr int KVBLK = 64;
constexpr float SCALE = 0.07216878364870322f;
constexpr float THR = 8.f;
#ifndef ATT_SDEPTH
#define ATT_SDEPTH 1
#endif
constexpr int SDEPTH = ATT_SDEPTH;
constexpr int SHM_V = 64 * 128 * 2, SHM_K = 64 * 192 * 2;
#define ATT_KSWZ(row, colB) ((row) * 384 + ((colB) ^ (((row) & 7) << 4)))
#define ATT_SBAR() __builtin_amdgcn_sched_barrier(0)
__device__ __forceinline__ int crow(int r, int hi) { return (r & 3) + 8 * (r >> 2) + 4 * hi; }
__device__ __forceinline__ void partialSM(f32x16& p0, f32x16& p1, float& m_reg, float& mn, float& alpha) {
    constexpr float C = SCALE * 1.4426950408889634f;
    float pmax = p0[0];
#pragma unroll
    for (int r = 1; r < 16; ++r) pmax = fmaxf(pmax, p0[r]);
#pragma unroll
    for (int r = 0; r < 16; ++r) pmax = fmaxf(pmax, p1[r]);
    { auto rr = __builtin_amdgcn_permlane32_swap(__float_as_uint(pmax), __float_as_uint(pmax), false, false);
      pmax = fmaxf(__uint_as_float(rr[0]), __uint_as_float(rr[1])); }
    if (__builtin_expect(__all(pmax - m_reg <= THR / SCALE), 1)) { mn = m_reg; alpha = 1.f; }
    else { mn = fmaxf(m_reg, pmax); alpha = __builtin_amdgcn_exp2f((m_reg - mn) * C); m_reg = mn; }
    const float mnC = -mn * C;
#pragma unroll
    for (int r = 0; r < 16; ++r) p0[r] = fmaf(p0[r], C, mnC);
#pragma unroll
    for (int r = 0; r < 16; ++r) p1[r] = fmaf(p1[r], C, mnC);
#pragma unroll
    for (int r = 0; r < 16; ++r) p0[r] = __builtin_amdgcn_exp2f(p0[r]);
}
__device__ __forceinline__ void finishSM(f32x16& p0, f32x16& p1, float alpha, float& l_reg, bf16x8& pa0, bf16x8& pa1, bf16x8& pa2, bf16x8& pa3) {
#pragma unroll
    for (int r = 0; r < 16; ++r) p1[r] = __builtin_amdgcn_exp2f(p1[r]);
    float ps = 0;
#pragma unroll
    for (int r = 0; r < 16; ++r) ps += p0[r];
#pragma unroll
    for (int r = 0; r < 16; ++r) ps += p1[r];
    { auto rr = __builtin_amdgcn_permlane32_swap(__float_as_uint(ps), __float_as_uint(ps), false, false);
      ps = __uint_as_float(rr[0]) + __uint_as_float(rr[1]); }
    l_reg = l_reg * alpha + ps;
#define ATT_PK4(P, BASE, OUT) do { unsigned a0 = cvt_pk_bf16(P[BASE + 0], P[BASE + 1]), a1 = cvt_pk_bf16(P[BASE + 2], P[BASE + 3]);   \
    unsigned b0 = cvt_pk_bf16(P[BASE + 4], P[BASE + 5]), b1 = cvt_pk_bf16(P[BASE + 6], P[BASE + 7]);                              \
    auto r0 = __builtin_amdgcn_permlane32_swap(a0, b0, false, false); auto r1 = __builtin_amdgcn_permlane32_swap(a1, b1, false, false); \
    u32x4 w = {r0[0], r1[0], r0[1], r1[1]}; OUT = *reinterpret_cast<bf16x8*>(&w); } while (0)
    ATT_PK4(p0, 0, pa0); ATT_PK4(p0, 8, pa1); ATT_PK4(p1, 0, pa2); ATT_PK4(p1, 8, pa3);
#undef ATT_PK4
}
__device__ __forceinline__ void qkt(f32x16& p0, f32x16& p1, const char* Ks, const bf16x8* qr, int r32, int hi) {
    p0 = f32x16{}; p1 = f32x16{};
#pragma unroll
    for (int d0 = 0; d0 < 12; ++d0) { const int cb = (d0 * 16 + hi * 8) * 2;
        const bf16x8 b0 = *reinterpret_cast<const bf16x8*>(Ks + ATT_KSWZ(r32, cb));
        const bf16x8 b1 = *reinterpret_cast<const bf16x8*>(Ks + ATT_KSWZ(32 + r32, cb));
        p0 = __builtin_amdgcn_mfma_f32_32x32x16_bf16(b0, qr[d0], p0, 0, 0, 0);
        p1 = __builtin_amdgcn_mfma_f32_32x32x16_bf16(b1, qr[d0], p1, 0, 0, 0); }
}
__device__ __forceinline__ int v_st(int k, int c) { const int kk = (k & ~0xC) | ((k & 4) << 1) | ((k & 8) >> 1); return ((kk >> 3) * 4 + (c >> 5)) * 512 + ((kk & 7) * 32 + (c & 31)) * 2; }
__device__ __forceinline__ int v_rd_base(int lane) { return ((lane & 3) << 3) | (((lane >> 2) & 3) << 6) | (((lane >> 4) & 1) << 5) | (((lane >> 5) & 1) << 8); }
constexpr int v_rd_off(int d0, int ks, int half) { return d0 * 512 + ks * 4096 + half * 2048; }
template <int OFF> __device__ __forceinline__ s16x4 tr_read(int vb) {
    s16x4 r; asm volatile("ds_read_b64_tr_b16 %0, %1 offset:%2" : "=&v"(r) : "v"(vb), "i"(OFF) : "memory"); return r;
}
template <int D0> __device__ __forceinline__ void pv_one(f32x16& od, int vb, bf16x8 pa0, bf16x8 pa1, bf16x8 pa2, bf16x8 pa3) {
    const s16x4 l0 = tr_read<v_rd_off(D0, 0, 0)>(vb), h0 = tr_read<v_rd_off(D0, 0, 1)>(vb), l1 = tr_read<v_rd_off(D0, 1, 0)>(vb), h1 = tr_read<v_rd_off(D0, 1, 1)>(vb);
    const s16x4 l2 = tr_read<v_rd_off(D0, 2, 0)>(vb), h2 = tr_read<v_rd_off(D0, 2, 1)>(vb), l3 = tr_read<v_rd_off(D0, 3, 0)>(vb), h3 = tr_read<v_rd_off(D0, 3, 1)>(vb);
    asm volatile("s_waitcnt lgkmcnt(0)" ::: "memory"); ATT_SBAR();
#define ATT_PK(L, H) (bf16x8){L[0], L[1], L[2], L[3], H[0], H[1], H[2], H[3]}
    od = __builtin_amdgcn_mfma_f32_32x32x16_bf16(pa0, ATT_PK(l0, h0), od, 0, 0, 0);
    od = __builtin_amdgcn_mfma_f32_32x32x16_bf16(pa1, ATT_PK(l1, h1), od, 0, 0, 0);
    od = __builtin_amdgcn_mfma_f32_32x32x16_bf16(pa2, ATT_PK(l2, h2), od, 0, 0, 0);
    od = __builtin_amdgcn_mfma_f32_32x32x16_bf16(pa3, ATT_PK(l3, h3), od, 0, 0, 0);
#undef ATT_PK
}
__device__ __forceinline__ void pv_d0(f32x16* o, int vb, bf16x8 pa0, bf16x8 pa1, bf16x8 pa2, bf16x8 pa3) {
    pv_one<0>(o[0], vb, pa0, pa1, pa2, pa3); pv_one<1>(o[1], vb, pa0, pa1, pa2, pa3); pv_one<2>(o[2], vb, pa0, pa1, pa2, pa3); pv_one<3>(o[3], vb, pa0, pa1, pa2, pa3);
}
__device__ __forceinline__ void body(const bf16_t* Qn, const bf16_t* Qr, const bf16_t* __restrict__ Kh, const bf16_t* __restrict__ Vh, const bf16_t* __restrict__ Kp, bf16_t* Ob, const int* __restrict__ posq, const float* __restrict__ invf, char* lds) {
    int tid_ = threadIdx.x; asm volatile("" : "+v"(tid_));
    const int tid = tid_, wid = tid >> 6, lane = tid & 63, r32 = lane & 31, hi = lane >> 5;
    char* V_lds = lds; char* K_lds = lds + 2 * SHM_V;
    float* ws = (float*)(lds + 2 * SHM_V + 2 * SHM_K) + wid * 64; float* li_l = ws; float* al_l = ws + 32;
    float m_reg = -1e30f, l_reg = 0; f32x16 o[4] = {}; bf16x8 qr[12];
    { const bf16_t* qa = Qn + (size_t)(wid * 32 + r32) * 1024 + hi * 8; const bf16_t* qb = Qr + (size_t)(wid * 32 + r32) * 512 + hi * 8;
#pragma unroll
      for (int d0 = 0; d0 < 8; ++d0) qr[d0] = *reinterpret_cast<const bf16x8*>(qa + d0 * 16);
#pragma unroll
      for (int d0 = 0; d0 < 4; ++d0) qr[8 + d0] = *reinterpret_cast<const bf16x8*>(qb + d0 * 16); }
    {
        const float posf = (float)posq[wid * 32 + r32];
#pragma unroll
        for (int t = 0; t < 2; ++t) {
            const f32x4 fa = *(const f32x4*)(invf + 16 * t + 8 * hi), fb = *(const f32x4*)(invf + 16 * t + 8 * hi + 4);
            float x1[8], x2[8], o1[8], o2[8];
            unpack8(*reinterpret_cast<const u32x4*>(&qr[8 + t]), x1); unpack8(*reinterpret_cast<const u32x4*>(&qr[10 + t]), x2);
#pragma unroll
            for (int j = 0; j < 8; ++j) { float cs, sn; rope_cs(posf * (j < 4 ? fa[j] : fb[j - 4]), cs, sn); o1[j] = x1[j] * cs - x2[j] * sn; o2[j] = x2[j] * cs + x1[j] * sn; }
            const u32x4 w1 = pack8(o1), w2 = pack8(o2);
            qr[8 + t] = *reinterpret_cast<const bf16x8*>(&w1); qr[10 + t] = *reinterpret_cast<const bf16x8*>(&w2);
        }
    }
    const int sr = tid >> 4, sc = (tid & 15) * 8, vst0 = v_st(sr, sc), vst1 = v_st(32 + sr, sc);
    const int pr = tid >> 3, pc = (tid & 7) * 8;
    const int vb0 = (int)(uintptr_t)V_lds + v_rd_base(lane);
    struct { bf16x8 vs0, vs1, ks0, ks1, kp; } sr_[SDEPTH];
#define ATT_SLOAD(i, k0) do { sr_[i].vs0 = *(const bf16x8*)(&Vh[(size_t)((k0) + sr) * 1024 + sc]); sr_[i].vs1 = *(const bf16x8*)(&Vh[(size_t)((k0) + 32 + sr) * 1024 + sc]); \
    sr_[i].ks0 = *(const bf16x8*)(&Kh[(size_t)((k0) + sr) * 1024 + sc]); sr_[i].ks1 = *(const bf16x8*)(&Kh[(size_t)((k0) + 32 + sr) * 1024 + sc]); \
    sr_[i].kp = *(const bf16x8*)(&Kp[(size_t)((k0) + pr) * 64 + pc]); } while (0)
#define ATT_SWRITE(b, i) do { *(bf16x8*)(V_lds + (b) * SHM_V + vst0) = sr_[i].vs0; *(bf16x8*)(V_lds + (b) * SHM_V + vst1) = sr_[i].vs1; const int kc = sc * 2; \
    *(bf16x8*)(K_lds + (b) * SHM_K + ATT_KSWZ(sr, kc)) = sr_[i].ks0; *(bf16x8*)(K_lds + (b) * SHM_K + ATT_KSWZ(32 + sr, kc)) = sr_[i].ks1; \
    *(bf16x8*)(K_lds + (b) * SHM_K + ATT_KSWZ(pr, 256 + pc * 2)) = sr_[i].kp; } while (0)
#define ATT_SWAIT() do { if constexpr (SDEPTH == 2) asm volatile("s_waitcnt vmcnt(5)" ::: "memory"); else asm volatile("s_waitcnt vmcnt(0)" ::: "memory"); } while (0)
#define ATT_RESC(a) do { if (__any((a) < 1.f)) { if (hi == 0) al_l[r32] = (a); asm volatile("s_waitcnt lgkmcnt(0)" ::: "memory"); \
    _Pragma("unroll") for (int d = 0; d < 4; ++d) _Pragma("unroll") for (int r = 0; r < 16; ++r) o[d][r] *= al_l[crow(r, hi)]; } } while (0)
    f32x16 pA0, pA1, pB0, pB1; float mnA, mnB, alA, alB; bf16x8 pa0, pa1, pa2, pa3; constexpr int NT = SEQ / KVBLK;
    constexpr int SE = 0, SO = SDEPTH - 1;
    ATT_SLOAD(SE, 0); asm volatile("s_waitcnt vmcnt(0)" ::: "memory"); ATT_SWRITE(0, SE); __syncthreads();
    qkt(pA0, pA1, K_lds, qr, r32, hi); partialSM(pA0, pA1, m_reg, mnA, alA);
    ATT_SLOAD(SO, KVBLK); if constexpr (SDEPTH == 2) ATT_SLOAD(SE, 2 * KVBLK);
    ATT_SWAIT(); ATT_SWRITE(1, SO); __syncthreads();
    for (int j = 1; j + 1 < NT; j += 2) {
        ATT_SBAR(); qkt(pB0, pB1, K_lds + SHM_K, qr, r32, hi);
        finishSM(pA0, pA1, alA, l_reg, pa0, pa1, pa2, pa3); ATT_SBAR();
        ATT_SLOAD(SO, (j + SDEPTH) * KVBLK); ATT_SBAR();
        pv_d0(o, vb0, pa0, pa1, pa2, pa3); partialSM(pB0, pB1, m_reg, mnB, alB);
        __syncthreads(); ATT_SWAIT(); ATT_SWRITE(0, SE);
        ATT_RESC(alB); __syncthreads();
        ATT_SBAR(); qkt(pA0, pA1, K_lds, qr, r32, hi);
        finishSM(pB0, pB1, alB, l_reg, pa0, pa1, pa2, pa3); ATT_SBAR();
        if (SDEPTH == 1 || j + 3 < NT) ATT_SLOAD(SE, (j + 1 + SDEPTH) * KVBLK); ATT_SBAR();
        pv_d0(o, vb0 + SHM_V, pa0, pa1, pa2, pa3); partialSM(pA0, pA1, m_reg, mnA, alA);
        __syncthreads(); ATT_SWAIT(); ATT_SWRITE(1, SO);
        ATT_RESC(alA); __syncthreads();
    }
    ATT_SBAR(); qkt(pB0, pB1, K_lds + SHM_K, qr, r32, hi);
    finishSM(pA0, pA1, alA, l_reg, pa0, pa1, pa2, pa3); ATT_SBAR();
    pv_d0(o, vb0, pa0, pa1, pa2, pa3); partialSM(pB0, pB1, m_reg, mnB, alB);
    __syncthreads(); ATT_RESC(alB);
    finishSM(pB0, pB1, alB, l_reg, pa0, pa1, pa2, pa3); ATT_SBAR();
    pv_d0(o, vb0 + SHM_V, pa0, pa1, pa2, pa3);
    if (hi == 0) li_l[r32] = l_reg; asm volatile("s_waitcnt lgkmcnt(0)" ::: "memory");
    float rli[16];
#pragma unroll
    for (int r = 0; r < 16; ++r) rli[r] = __builtin_amdgcn_rcpf(li_l[crow(r, hi)]);
    bf16_t* Ow = Ob + (size_t)(wid * 32) * 1024;
#pragma unroll
    for (int r = 0; r < 16; ++r) { const int orow = crow(r, hi);
#pragma unroll
        for (int d0 = 0; d0 < 4; ++d0) Ow[(size_t)orow * 1024 + d0 * 32 + r32] = f2bf(o[d0][r] * rli[r]); }
#undef ATT_SLOAD
#undef ATT_SWRITE
#undef ATT_SWAIT
#undef ATT_RESC
}
}

__device__ __forceinline__ void attn_phase(const Params& p, char* smem, int bid, int G) {
    bf16_t* Qn = (bf16_t*)(p.ws + OFF_A); const bf16_t* Qr = (const bf16_t*)(p.ws + OFF_QR);
    const bf16_t* Kn = (const bf16_t*)(p.ws + OFF_C); const bf16_t* V = (const bf16_t*)(p.ws + OFF_D); const bf16_t* Kp = (const bf16_t*)(p.ws + OFF_KPE);
    for (int u = bid; u < 1024; u += G) {
        const int qb = u & 15, h = (u >> 4) & 7, b = u >> 7;
        const size_t r0 = (size_t)b * SEQ, q0 = r0 + (size_t)qb * 256;
        __syncthreads();
        att::body(Qn + q0 * 1024 + 128 * h, Qr + q0 * 512 + 64 * h, Kn + r0 * 1024 + 128 * h, V + r0 * 1024 + 128 * h, Kp + r0 * 64, Qn + q0 * 1024 + 128 * h, p.pos + q0, (const float*)(p.ws + OFF_INVF), smem);
    }
    __syncthreads();
}

__device__ __forceinline__ void phase_prep(const Params& p, LAS unsigned char* lds, int gw, int nw, int wid, int lane) {
    bf16_t* W = (bf16_t*)p.ws;
    WtCtx c{(LAS float*)(lds + wid * 8448), gw, nw, lane, 0};
#pragma unroll 1
    for (int f = 0; f < 2; ++f) {
        const float* wg = f ? p.ffn2_wg : p.ffn1_wg; const float* wu = f ? p.ffn2_wu : p.ffn1_wu; const float* wd = f ? p.ffn2_wd : p.ffn1_wd;
        bf16_t* gu = W + (f ? EW2GU : EW1GU); bf16_t* dn = W + (f ? EW2D : EW1D);
        wt_job(c, wg, 1024, 2816, 0, 2816, gu, 1024, 0, 128, 256);
        wt_job(c, wu, 1024, 2816, 0, 2816, gu, 1024, 128, 128, 256);
        wt_job(c, wd, 2816, 1024, 0, 1024, dn, 2816, 0, 1024, 0);
    }
    { bf16_t* Win = W + EWIN;
      wt_job(c, p.w_in, 1024, 4800, 0, 1024, Win, 1024, 0, 1024, 0);
      wt_job(c, p.w_in, 1024, 4800, 1024, 1024, Win, 1024, 1024, 1024, 0);
      wt_job(c, p.w_in, 1024, 4800, 2432, 256, Win, 1024, 2048, 256, 0);
      wt_job(c, p.w_in, 1024, 4800, 2048, 384, Win, 1024, 2304, 384, 0);
      wt_job(c, p.w_in, 1024, 4800, 2688, 64, Win, 1024, 2688, 64, 0);
      wt_job(c, p.w_in, 1024, 4800, 2752, 1024, Win, 1024, 2816, 1024, 0);
      wt_job(c, p.w_in, 1024, 4800, 3776, 1024, Win, 1024, 3840, 1024, 0);
      const int gt = gw * 64 + lane;
      for (int i = gt; i < 8192; i += nw * 64) ((u32x4*)(Win + 2752 * 1024))[i] = (u32x4){0u, 0u, 0u, 0u};
    }
#pragma unroll 1
    for (int db = 0; db < 16; ++db) {
        const int dir = db >> 3, blk = db & 7;
        wt_job(c, p.lru_wr + (size_t)db * 16384, 128, 128, 0, 128, W + EWG + (size_t)blk * 65536, 128, dir * 256, 128, 0);
        wt_job(c, p.lru_wi + (size_t)db * 16384, 128, 128, 0, 128, W + EWG + (size_t)blk * 65536, 128, dir * 256 + 128, 128, 0);
    }
#pragma unroll 1
    for (int h = 0; h < 8; ++h) {
        wt_job(c, p.w_uq, 384, 1536, 192 * h, 128, W + EWUQ, 384, 128 * h, 128, 0);
        wt_job(c, p.w_uq, 384, 1536, 192 * h + 128, 32, W + EWUQ, 384, 1024 + 256 * (h >> 2) + 32 * (h & 3), 32, 0);
        wt_job(c, p.w_uq, 384, 1536, 192 * h + 160, 32, W + EWUQ, 384, 1024 + 256 * (h >> 2) + 128 + 32 * (h & 3), 32, 0);
    }
    wt_job(c, p.w_ukv, 256, 2048, 0, 2048, W + EWUKV, 256, 0, 2048, 0);
    wt_job(c, p.w_lru_out, 1024, 1024, 0, 1024, W + EWLO, 1024, 0, 1024, 0);
    wt_job(c, p.w_mla_out, 1024, 1024, 0, 1024, W + EWMO, 1024, 0, 1024, 0);
    wt_job(c, p.w_o, 1024, 1024, 0, 1024, W + EWO, 1024, 0, 1024, 0);
    wt_job(c, p.ple_wg, 1024, 1024, 0, 1024, W + EWPG, 1024, 0, 1024, 0);
    wt_job(c, p.ple_wp, 256, 1024, 0, 1024, W + EWPP, 256, 0, 1024, 0);
    if (gw == 0 && lane == 0) { float* t = (float*)(p.ws + OFF_INVF);
#pragma unroll
        for (int i = 0; i < 32; ++i) t[i] = p.inv_freq[i]; }
    norm_rows(p.x, p.ffn1_norm, (bf16_t*)(p.ws + OFF_A), gw, nw, lane);
}

template <class Epi> __device__ __forceinline__ void run_gemm(LAS unsigned char* lds, const bf16_t* A, const bf16_t* Bt, int N, int K, const Epi& E, int bid, int G) {
    pg8::Gemm g{A, Bt, MT, N, K}; pg8::StaticOrder S; S.init(MT, N, G, bid);
    pg8::gemm_phase<Epi, pg8::StaticOrder, false>(lds, g, S, E, nullptr);
}

__device__ __forceinline__ void run_phase(const Params& p, int ph, unsigned char* smem) {
    LAS unsigned char* lds = (LAS unsigned char*)smem;
    int tid_ = threadIdx.x; asm volatile("" : "+v"(tid_));
    int bid = blockIdx.x, G = gridDim.x; asm volatile("" : "+s"(bid), "+s"(G));
    const int tid = tid_, wid = tid >> 6, lane = tid & 63, nw = G * 8, gw = bid * 8 + wid;
    unsigned char* ws = p.ws; const bf16_t* W = (const bf16_t*)ws;
    bf16_t* bA = (bf16_t*)(ws + OFF_A); bf16_t* bD = (bf16_t*)(ws + OFF_D);
#ifndef PH_MASK
#define PH_MASK 0x3ffff
#endif
#define PH_ON(k) constexpr (((PH_MASK) >> (k)) & 1)
    switch (ph) {
    case 0: if PH_ON(0) phase_prep(p, lds, gw, nw, wid, lane); break;
    case 1: case 13: if PH_ON(1) { EpiSwiGLU E{(bf16_t*)(ws + OFF_B)}; run_gemm(lds, bA, W + (ph == 1 ? EW1GU : EW2GU), 5632, 1024, E, bid, G); } break;
    case 2: case 14: if PH_ON(2) { EpiResid E{ph == 2 ? p.x : p.out, p.out, 0.5f}; run_gemm(lds, (const bf16_t*)(ws + OFF_B), W + (ph == 2 ? EW1D : EW2D), 1024, 2816, E, bid, G); } break;
    case 3: if PH_ON(3) norm_rows(p.out, p.mix_norm, bA, gw, nw, lane); break;
    case 4: if PH_ON(4) { EpiWin E{ws}; run_gemm(lds, bA, W + EWIN, 4864, 1024, E, bid, G); } break;
    case 5: if PH_ON(5) { lru_phase<false>(p, lds, bid, G); mid_rows(p, gw, nw, lane); } break;
    case 6: if PH_ON(6) lru_phase<true>(p, lds, bid, G); break;
    case 7: if PH_ON(7) { EpiGateMul E{bD, bD, (bf16_t*)(ws + OFF_B), 0}; run_gemm(lds, bA, W + EWLO, 1024, 1024, E, bid, G); } break;
    case 8: if PH_ON(8) { EpiQ Eq{bA, (bf16_t*)(ws + OFF_QR)}; run_gemm(lds, (const bf16_t*)(ws + OFF_CQN), W + EWUQ, 1536, 384, Eq, bid, G);
              EpiKV Ek{(bf16_t*)(ws + OFF_C), (bf16_t*)(ws + OFF_D)}; run_gemm(lds, (const bf16_t*)(ws + OFF_CKVN), W + EWUKV, 2048, 256, Ek, bid, G); } break;
    case 9: if PH_ON(9) attn_phase(p, (char*)smem, bid, G); break;
    case 10: if PH_ON(10) { EpiGateMul E{(const bf16_t*)(ws + OFF_E), (const bf16_t*)(ws + OFF_B), (bf16_t*)(ws + OFF_C), 1}; run_gemm(lds, bA, W + EWMO, 1024, 1024, E, bid, G); } break;
    case 11: if PH_ON(11) { EpiResid E{p.out, p.out, 1.0f}; run_gemm(lds, (const bf16_t*)(ws + OFF_C), W + EWO, 1024, 1024, E, bid, G); } break;
    case 12: if PH_ON(12) norm_rows(p.out, p.ffn2_norm, bA, gw, nw, lane); break;
    case 15: if PH_ON(15) { norm_rows(p.out, p.ple_norm, bA, gw, nw, lane);
               bf16_t* pb = (bf16_t*)(ws + OFF_F);
               for (int i = gw * 64 + lane; i < MT * 256 / 8; i += nw * 64) { const float4 a = ((const float4*)p.p)[2 * i], b = ((const float4*)p.p)[2 * i + 1];
                   const float e[8] = {a.x, a.y, a.z, a.w, b.x, b.y, b.z, b.w}; ((u32x4*)pb)[i] = pack8(e); } } break;
    case 16: if PH_ON(16) { EpiF32Act<1> Eg{(float*)(ws + OFF_B)}; run_gemm(lds, bA, W + EWPG, 1024, 1024, Eg, bid, G);
               EpiF32Act<0> Ep{(float*)(ws + OFF_D)}; run_gemm(lds, (const bf16_t*)(ws + OFF_F), W + EWPP, 1024, 256, Ep, bid, G); } break;
    case 17: if PH_ON(17) final_rows(p, gw, nw, lane); break;
    default: break;
    }
}

typedef const __attribute__((address_space(4))) Params* KP;
#if defined(__HIP_DEVICE_COMPILE__)
#define MK_PHASE(k) do { KP q = (KP)__builtin_amdgcn_kernarg_segment_ptr(); asm volatile("" : "+s"(q)); const Params lp = *q; run_phase(lp, (k), smem); } while (0)
#else
#define MK_PHASE(k) do { (void)smem; } while (0)
#endif
#if MK_ONE_LAUNCH
__device__ __forceinline__ void grid_bar(unsigned* ctr, unsigned target) {
    __builtin_amdgcn_fence(__ATOMIC_RELEASE, "agent");
    asm volatile("s_waitcnt vmcnt(0) lgkmcnt(0)" ::: "memory");
    __syncthreads();
    if (threadIdx.x == 0) {
        __hip_atomic_fetch_add(ctr, 1u, __ATOMIC_RELAXED, __HIP_MEMORY_SCOPE_AGENT);
        while (__hip_atomic_load(ctr, __ATOMIC_RELAXED, __HIP_MEMORY_SCOPE_AGENT) < target) __builtin_amdgcn_s_sleep(2);
    }
    __syncthreads();
    __builtin_amdgcn_fence(__ATOMIC_ACQUIRE, "agent");
    asm volatile("s_waitcnt vmcnt(0)" ::: "memory");
}
__global__ void __launch_bounds__(512, 2) mk(Params p_unused) {
    extern __shared__ __attribute__((aligned(16))) unsigned char smem[];
    cg::grid_group grid = cg::this_grid();
    unsigned* ctr = nullptr; unsigned G = gridDim.x;
#if defined(__HIP_DEVICE_COMPILE__)
    { KP q = (KP)__builtin_amdgcn_kernarg_segment_ptr(); ctr = (unsigned*)(q->ws + OFF_BAR); }
#endif
#define GB(k) grid_bar(ctr, (unsigned)(k) * G)
    if (blockIdx.x == 0 && threadIdx.x == 0) __hip_atomic_store(ctr, 0u, __ATOMIC_RELAXED, __HIP_MEMORY_SCOPE_AGENT);
    grid.sync();
    MK_PHASE(0); GB(1); MK_PHASE(1); GB(2); MK_PHASE(2); GB(3); MK_PHASE(3); GB(4); MK_PHASE(4); GB(5); MK_PHASE(5); GB(6);
    MK_PHASE(6); GB(7); MK_PHASE(7); GB(8); MK_PHASE(8); GB(9); MK_PHASE(9); GB(10); MK_PHASE(10); GB(11); MK_PHASE(11); GB(12);
    MK_PHASE(12); GB(13); MK_PHASE(13); GB(14); MK_PHASE(14); GB(15); MK_PHASE(15); GB(16); MK_PHASE(16); GB(17); MK_PHASE(17);
#undef GB
}
#else
template <int PH> __global__ void __launch_bounds__(512, 2) mkp(Params p_unused) {
    extern __shared__ __attribute__((aligned(16))) unsigned char smem[];
    MK_PHASE(PH);
}
template <int PH> static void launch_phases(const Params& p, int grid, hipStream_t stream, bool setattr) {
    if constexpr (PH < NPHASE) {
        if (setattr) { if (hipFuncSetAttribute((const void*)mkp<PH>, hipFuncAttributeMaxDynamicSharedMemorySize, LDS_BYTES) != hipSuccess) fprintf(stderr, "kernel_launch: hipFuncSetAttribute failed (phase %d)\n", PH); }
        else {
#if defined(MK_DEBUG)
            if (PH == 9) hipLaunchKernelGGL(chk, dim3(1), dim3(64), 0, stream, p, 89);
            if (PH == 7) hipLaunchKernelGGL(chk, dim3(1), dim3(64), 0, stream, p, 70);
            if (PH == 10) hipLaunchKernelGGL(chk, dim3(1), dim3(64), 0, stream, p, 90);
            if (PH == 11) hipLaunchKernelGGL(chk, dim3(1), dim3(64), 0, stream, p, 91);
            if (PH == 14) hipLaunchKernelGGL(chk, dim3(1), dim3(64), 0, stream, p, 92);
            if (PH == 17) hipLaunchKernelGGL(chk, dim3(1), dim3(64), 0, stream, p, 93);
#endif
            hipLaunchKernelGGL(mkp<PH>, dim3(grid), dim3(512), LDS_BYTES, stream, p);
#if defined(MK_DEBUG)
            if (true) hipLaunchKernelGGL(chk, dim3(1), dim3(64), 0, stream, p, PH);
            if (PH == NPHASE - 1) hipLaunchKernelGGL(chk, dim3(1), dim3(64), 0, stream, p, MK_DEBUG);
#endif
        }
        launch_phases<PH + 1>(p, grid, stream, setattr);
    }
}
#endif

extern "C" void kernel_launch(void* const* d_in, const int* in_sizes, int n_in, void* d_out, int out_size, void* d_ws, size_t ws_size, hipStream_t stream) {
    static int grid = 0;
    if (grid == 0) {
        if (n_in != 32 || in_sizes[0] != MT * DM || out_size != MT * DM || ws_size < WS_NEED) {
            fprintf(stderr, "kernel_launch: unexpected shapes: n_in %d in0 %d out %d ws %zu (need %zu)\n", n_in, n_in > 0 ? in_sizes[0] : -1, out_size, ws_size, (size_t)WS_NEED); grid = -1; return; }
        int dev = 0, cus = 0, per_cu = 0;
        (void)hipGetDevice(&dev); (void)hipDeviceGetAttribute(&cus, hipDeviceAttributeMultiprocessorCount, dev);
#if MK_ONE_LAUNCH
        if (hipFuncSetAttribute((const void*)mk, hipFuncAttributeMaxDynamicSharedMemorySize, LDS_BYTES) != hipSuccess) { fprintf(stderr, "kernel_launch: hipFuncSetAttribute failed\n"); grid = -1; return; }
        if (hipOccupancyMaxActiveBlocksPerMultiprocessor(&per_cu, (const void*)mk, 512, LDS_BYTES) != hipSuccess || per_cu < 1) { fprintf(stderr, "kernel_launch: occupancy query gives %d\n", per_cu); per_cu = 1; }
#else
        { Params z{}; launch_phases<0>(z, 0, stream, true); }
#endif
        (void)hipGetLastError();
        grid = cus;
    }
    if (grid < 0) return;
    Params p{};
    p.x = (const float*)d_in[0]; p.p = (const float*)d_in[1]; p.pos = (const int*)d_in[2];
    p.ffn1_norm = (const float*)d_in[3]; p.ffn1_wg = (const float*)d_in[4]; p.ffn1_wu = (const float*)d_in[5]; p.ffn1_wd = (const float*)d_in[6];
    p.mix_norm = (const float*)d_in[7]; p.w_in = (const float*)d_in[8]; p.conv_w = (const float*)d_in[9]; p.conv_b = (const float*)d_in[10];
    p.lru_wr = (const float*)d_in[11]; p.lru_br = (const float*)d_in[12]; p.lru_wi = (const float*)d_in[13]; p.lru_bi = (const float*)d_in[14]; p.lru_lam = (const float*)d_in[15];
    p.w_lru_out = (const float*)d_in[16]; p.q_norm = (const float*)d_in[17]; p.w_uq = (const float*)d_in[18]; p.kv_norm = (const float*)d_in[19]; p.w_ukv = (const float*)d_in[20];
    p.w_mla_out = (const float*)d_in[21]; p.w_o = (const float*)d_in[22]; p.ffn2_norm = (const float*)d_in[23]; p.ffn2_wg = (const float*)d_in[24]; p.ffn2_wu = (const float*)d_in[25];
    p.ffn2_wd = (const float*)d_in[26]; p.ple_norm = (const float*)d_in[27]; p.ple_wg = (const float*)d_in[28]; p.ple_wp = (const float*)d_in[29]; p.ple_pn = (const float*)d_in[30];
    p.final_norm = (const float*)d_in[31];
    p.out = (float*)d_out; p.ws = (unsigned char*)d_ws;
    for (int i = 0; i < 32; ++i) p.inv_freq[i] = (float)pow(10000.0, -(double)(2 * i) / 64.0);
#if MK_ONE_LAUNCH
    void* args[] = {&p};
    hipError_t e = hipLaunchCooperativeKernel((const void*)mk, dim3(grid), dim3(512), args, LDS_BYTES, stream);
    if (e != hipSuccess) fprintf(stderr, "kernel_launch: cooperative launch failed: %s (grid %d)\n", hipGetErrorString(e), grid);
#else
    launch_phases<0>(p, grid, stream, false);
    hipError_t e = hipPeekAtLastError();
    if (e != hipSuccess) fprintf(stderr, "kernel_launch: launch failed: %s\n", hipGetErrorString(e));
#endif
}
```

```cpp
#include <hip/hip_runtime.h>
#include <hip/hip_cooperative_groups.h>
#include <cstdio>
#include <cmath>
namespace cg = cooperative_groups;
#ifndef MK_ONE_LAUNCH
#define MK_ONE_LAUNCH 1
#endif
namespace pg8 {
#define PG8_LAS __attribute__((address_space(3)))
typedef unsigned short bf16_t;
typedef short bf16x8 __attribute__((ext_vector_type(8)));
typedef float f32x4 __attribute__((ext_vector_type(4)));
typedef unsigned u32x4 __attribute__((ext_vector_type(4)));
constexpr int BM = 256, BK = 64, HALF = 128, HTB = HALF * BK * 2  , STAGE_BYTES = 8 * HTB, NXCD = 8, WGM = 8;

__host__ __device__ __forceinline__ int lds_byte(int r, int c) { const int st = (r >> 4) * 2 + (c >> 5), rr = r & 15, cc = c & 31, ob = rr * 64 + cc * 2; return st * 1024 + (ob ^ (((ob >> 9) & 1) << 5)); }
__host__ __device__ __forceinline__ void stage_rc(int b, int& R, int& C) { const int st = b / 1024, sb = b % 1024, swz = sb ^ (((sb >> 9) & 1) << 5); R = (st >> 1) * 16 + swz / 64; C = (st & 1) * 32 + (swz % 64) / 2; }
__host__ __device__ __forceinline__ int perm32(int rho) { const int n = rho >> 4, i = rho & 15; return 8 * (i >> 2) + 4 * n + (i & 3); }

struct Unit { int pm, pn; };
struct Gemm { const bf16_t* A; const bf16_t* Bt; int M, N, K; };

struct StaticOrder {
    int nM, nN, nwg, G, c;
    __host__ __device__ void init(int M, int N, int G_, int c_) { nM = M / BM; nN = N / BM; nwg = nM * nN; G = G_; c = c_; }
    __host__ __device__ bool next(int i, Unit& u) const {
        const long L = (long)i * G + c; if (L >= nwg) return false;
        int wgid = (int)L; { const int q = nwg / NXCD, r = nwg % NXCD, xcd = wgid % NXCD, off = wgid / NXCD; wgid = (xcd < r ? xcd * (q + 1) : r * (q + 1) + (xcd - r) * q) + off; }
        const int nig = WGM * nN, gid = wgid / nig, fm = gid * WGM, gsz = (nM - fm) < WGM ? (nM - fm) : WGM;
        u.pm = fm + ((wgid % nig) % gsz); u.pn = (wgid % nig) / gsz; return true;
    }
    __device__ __forceinline__ void a_ready(const Unit&) const {}
    __device__ __forceinline__ void done(const Unit&) const {}
};
typedef float cvt_f32x2 __attribute__((ext_vector_type(2)));
typedef __bf16 cvt_bf16x2 __attribute__((ext_vector_type(2)));
__device__ __forceinline__ unsigned cvt_pk_bf16(float lo, float hi) { const cvt_f32x2 v = {lo, hi}; const cvt_bf16x2 r = __builtin_convertvector(v, cvt_bf16x2); return __builtin_bit_cast(unsigned, r); }
typedef float f32x2 __attribute__((ext_vector_type(2)));
template <class Epi, class Sched, bool STAMP = false>
__device__ __forceinline__ void gemm_phase(PG8_LAS unsigned char* lds, const Gemm g, const Sched S, const Epi E, unsigned long long* stamps) {
    int tid_ = threadIdx.x; asm volatile("" : "+v"(tid_));
    const int tid = tid_, wid = __builtin_amdgcn_readfirstlane(tid >> 6), lane = tid & 63, wr = wid >> 2, wc = wid & 3, fr = lane & 15, fq = lane >> 4;
    const int K = g.K, nt = K / BK;
    int ts_lo = 0, ts_hi = 0, nts = 0; const unsigned long long rt_entry = STAMP ? (unsigned long long)wall_clock64() : 0ull;
#define PG8_STAMP() do { if (STAMP && wid == 0 && nts < 64) { const unsigned long long _c = (unsigned long long)clock64(); \
        ts_lo = (lane == nts) ? (int)(unsigned)_c : ts_lo; ts_hi = (lane == nts) ? (int)(unsigned)(_c >> 32) : ts_hi; ++nts; } } while (0)
    PG8_STAMP();
    unsigned voffA[2], voffB[2];
#pragma unroll
    for (int i = 0; i < 2; ++i) { int R, C; stage_rc(tid * 16 + i * 8192, R, C); const int Rb = Epi::PERM ? ((R & ~31) + perm32(R & 31)) : R;
        voffA[i] = (unsigned)(R * K + C) * 2u; voffB[i] = (unsigned)(Rb * K + C) * 2u; }
    const size_t kstep = (size_t)(BK * 2);
    const size_t hstep = (size_t)HALF * K * 2;
    const size_t tstep = 2 * hstep;
    const unsigned ldsw = (unsigned)wid * 1024u;
    const int aoff = lds_byte(wr * 64 + fr, fq * 8), boff = lds_byte(wc * 32 + fr, fq * 8);
#define PG8_SA(b, h) (((b) * 2 + (h)) * HTB)
#define PG8_SB(b, h) ((4 + (b) * 2 + (h)) * HTB)
#define PG8_STAGE(bufoff, gbase, voff) do { _Pragma("unroll") for (int _i = 0; _i < 2; ++_i) \
        __builtin_amdgcn_global_load_lds((const unsigned*)((const char*)(gbase) + (voff)[_i]), (PG8_LAS unsigned*)(lds + (bufoff) + ldsw + _i * 8192), 16, 0, 0); } while (0)
#define PG8_LDA(dst, b, h) do { _Pragma("unroll") for (int m = 0; m < 4; ++m) _Pragma("unroll") for (int k = 0; k < 2; ++k) dst[m][k] = *(const PG8_LAS bf16x8*)(lds + PG8_SA(b, h) + aoff + m * 2048 + k * 1024); } while (0)
#define PG8_LDB(dst, b, h) do { _Pragma("unroll") for (int n = 0; n < 2; ++n) _Pragma("unroll") for (int k = 0; k < 2; ++k) dst[n][k] = *(const PG8_LAS bf16x8*)(lds + PG8_SB(b, h) + boff + n * 2048 + k * 1024); } while (0)
#define PG8_MMA(ai, bj, At, Bt) do { __builtin_amdgcn_s_setprio(1); _Pragma("unroll") for (int m = 0; m < 4; ++m) _Pragma("unroll") for (int n = 0; n < 2; ++n) _Pragma("unroll") for (int k = 0; k < 2; ++k) \
        acc[ai][bj][m][n] = __builtin_amdgcn_mfma_f32_16x16x32_bf16(Bt[n][k], At[m][k], acc[ai][bj][m][n], 0, 0, 0); __builtin_amdgcn_s_setprio(0); } while (0)
#define PG8_WAIT_V(n) asm volatile("s_waitcnt vmcnt(" #n ")" ::: "memory")
#define PG8_WAIT_L(n) asm volatile("s_waitcnt lgkmcnt(" #n ")" ::: "memory")
#define PG8_BAR __builtin_amdgcn_s_barrier()
#define PG8_SCHED __builtin_amdgcn_sched_barrier(0)
    Unit cur, nxt; int ui = 0;
    if (!S.next(0, cur)) return;
    f32x4 acc[2][2][4][2];
#pragma unroll
    for (int a = 0; a < 2; ++a)
#pragma unroll
        for (int b = 0; b < 2; ++b)
#pragma unroll
            for (int m = 0; m < 4; ++m)
#pragma unroll
                for (int n = 0; n < 2; ++n) acc[a][b][m][n] = (f32x4){0.f, 0.f, 0.f, 0.f};
    bf16x8 At[4][2], B0[2][2], B1[2][2];
    const char* cA = (const char*)g.A + (size_t)cur.pm * tstep; const char* cB = (const char*)g.Bt + (size_t)cur.pn * tstep;
    S.a_ready(cur);
    PG8_STAGE(PG8_SB(0, 0), cB, voffB); PG8_STAGE(PG8_SA(0, 0), cA, voffA); PG8_STAGE(PG8_SB(0, 1), cB + hstep, voffB); PG8_STAGE(PG8_SA(0, 1), cA + hstep, voffA);
    if (wr == 1) PG8_BAR;
    PG8_WAIT_V(4); PG8_BAR;
    PG8_STAGE(PG8_SB(1, 0), cB + kstep, voffB); PG8_STAGE(PG8_SA(1, 0), cA + kstep, voffA); PG8_STAGE(PG8_SB(1, 1), cB + hstep + kstep, voffB);
    PG8_WAIT_V(6); PG8_BAR;
    PG8_STAMP();
    for (;;) {
        const bool has_next = S.next(ui + 1, nxt);
        const char* nA = has_next ? (const char*)g.A + (size_t)nxt.pm * tstep : cA; const char* nB = has_next ? (const char*)g.Bt + (size_t)nxt.pn * tstep : cB;
        for (int t = 0; t < nt; t += 2) {
            const bool last = (t == nt - 2);
            const char* a1 = cA + (size_t)(t + 1) * kstep;
            const char* a2 = last ? nA : cA + (size_t)(t + 2) * kstep; const char* b2 = last ? nB : cB + (size_t)(t + 2) * kstep;
            const char* a3 = a2 + kstep; const char* b3 = b2 + kstep;
            if (last && has_next) S.a_ready(nxt);
            PG8_LDB(B0, 0, 0); PG8_SCHED; PG8_LDA(At, 0, 0); PG8_STAGE(PG8_SA(1, 1), a1 + hstep, voffA);
            PG8_WAIT_L(8); PG8_BAR; PG8_WAIT_L(0); PG8_MMA(0, 0, At, B0); PG8_BAR; PG8_SCHED;
            PG8_LDB(B1, 0, 1); PG8_STAGE(PG8_SB(0, 0), b2, voffB);
            PG8_BAR; PG8_WAIT_L(0); PG8_MMA(0, 1, At, B1); PG8_BAR;
            PG8_LDA(At, 0, 1); PG8_STAGE(PG8_SA(0, 0), a2, voffA);
            PG8_BAR; PG8_WAIT_L(0); PG8_MMA(1, 0, At, B0); PG8_BAR; PG8_SCHED;
            PG8_STAGE(PG8_SB(0, 1), b2 + hstep, voffB);
            PG8_WAIT_V(6); PG8_BAR; PG8_MMA(1, 1, At, B1); PG8_BAR;
            PG8_LDB(B0, 1, 0); PG8_SCHED; PG8_LDA(At, 1, 0); PG8_STAGE(PG8_SA(0, 1), a2 + hstep, voffA);
            PG8_WAIT_L(8); PG8_BAR; PG8_WAIT_L(0); PG8_MMA(0, 0, At, B0); PG8_BAR; PG8_SCHED;
            PG8_LDB(B1, 1, 1); PG8_STAGE(PG8_SB(1, 0), b3, voffB);
            PG8_BAR; PG8_WAIT_L(0); PG8_MMA(0, 1, At, B1); PG8_BAR;
            PG8_LDA(At, 1, 1); PG8_STAGE(PG8_SA(1, 0), a3, voffA);
            PG8_BAR; PG8_WAIT_L(0); PG8_MMA(1, 0, At, B0); PG8_BAR; PG8_SCHED;
            PG8_STAGE(PG8_SB(1, 1), b3 + hstep, voffB);
            PG8_WAIT_V(6); PG8_BAR; PG8_MMA(1, 1, At, B1); PG8_BAR;
        }
        PG8_STAMP();
        if constexpr (!Epi::AFTER_DRAIN) { E(acc, cur, wr, wc, fr, fq); S.done(cur); }
        PG8_STAMP();
        if (!has_next) break;
#pragma unroll
        for (int a = 0; a < 2; ++a)
#pragma unroll
            for (int b = 0; b < 2; ++b)
#pragma unroll
                for (int m = 0; m < 4; ++m)
#pragma unroll
                    for (int n = 0; n < 2; ++n) acc[a][b][m][n] = (f32x4){0.f, 0.f, 0.f, 0.f};
        cur = nxt; cA = nA; cB = nB; ++ui;
    }
    PG8_WAIT_V(0);
    if (wr == 0) PG8_BAR;
    PG8_BAR;
    if constexpr (Epi::AFTER_DRAIN) { E.fused(acc, cur, wr, wc, fr, fq, lds, wid, lane); S.done(cur); }
    PG8_STAMP();
    if (STAMP && wid == 0) { stamps[lane] = lane < nts ? (((unsigned long long)(unsigned)ts_hi << 32) | (unsigned)ts_lo) : 0ull;
        if (lane == 62) stamps[62] = rt_entry; if (lane == 63) stamps[63] = (unsigned long long)wall_clock64(); }
#undef PG8_STAMP
#undef PG8_SA
#undef PG8_SB
#undef PG8_STAGE
#undef PG8_LDA
#undef PG8_LDB
#undef PG8_MMA
#undef PG8_WAIT_V
#undef PG8_WAIT_L
#undef PG8_BAR
#undef PG8_SCHED
}
}

#define LAS __attribute__((address_space(3)))
typedef unsigned short bf16_t;
typedef short bf16x8 __attribute__((ext_vector_type(8)));
typedef short s16x4 __attribute__((ext_vector_type(4)));
typedef float f32x4 __attribute__((ext_vector_type(4)));
typedef float f32x16 __attribute__((ext_vector_type(16)));
typedef unsigned u32x4 __attribute__((ext_vector_type(4)));
typedef unsigned u32x2 __attribute__((ext_vector_type(2)));
using pg8::cvt_pk_bf16;

constexpr int MT = 32768, SEQ = 4096, DM = 1024, DFF = 2816;
constexpr float EPS = 1e-6f;
constexpr size_t UU = 67108864ull;
constexpr size_t EW1GU = 0, EW1D = 5767168, EWIN = 8650752, EWG = 13631488, EWUQ = 14155776, EWUKV = 14745600, EWLO = 15269888,
                 EWMO = 16318464, EWO = 17367040, EW2GU = 18415616, EW2D = 24182784, EWPG = 27066368, EWPP = 28114944;
constexpr size_t OFF_INVF = 55ull << 20;
constexpr size_t OFF_RS = (55ull << 20) + (600ull << 10);
constexpr size_t OFF_BAR = (55ull << 20) + (512ull << 10);
constexpr size_t OFF_CARP = 56ull << 20, OFF_CARH = 60ull << 20;
constexpr size_t OFF_A = UU, OFF_B = 2 * UU, OFF_C = 3 * UU, OFF_D = 4 * UU, OFF_E = 5 * UU, OFF_F = 6 * UU, OFF_G = 6 * UU + UU / 2, OFF_H = 6 * UU + 3 * UU / 4;
constexpr size_t OFF_CQN = OFF_H, OFF_CKVN = OFF_CQN + 3 * UU / 8, OFF_KPE = OFF_CKVN + UU / 4, OFF_QR = OFF_KPE + UU / 16;
constexpr size_t WS_NEED = 8 * UU;
static_assert(OFF_QR + UU / 2 <= WS_NEED, "workspace map");
constexpr int LDS_BYTES = 152576;
constexpr int NPHASE = 18;

struct Params {
    const float *x, *p; const int* pos;
    const float *ffn1_norm, *ffn1_wg, *ffn1_wu, *ffn1_wd, *mix_norm, *w_in, *conv_w, *conv_b, *lru_wr, *lru_br, *lru_wi, *lru_bi, *lru_lam, *w_lru_out,
        *q_norm, *w_uq, *kv_norm, *w_ukv, *w_mla_out, *w_o, *ffn2_norm, *ffn2_wg, *ffn2_wu, *ffn2_wd, *ple_norm, *ple_wg, *ple_wp, *ple_pn, *final_norm;
    float* out; unsigned char* ws;
    float inv_freq[32];
};

__device__ __forceinline__ float bflo(unsigned w) { return __uint_as_float(w << 16); }
__device__ __forceinline__ float bfhi(unsigned w) { return __uint_as_float(w & 0xffff0000u); }
__device__ __forceinline__ float bf2f(bf16_t b) { return __uint_as_float(((unsigned)b) << 16); }
__device__ __forceinline__ bf16_t f2bf(float f) { return (bf16_t)(cvt_pk_bf16(f, f) & 0xffffu); }
__device__ __forceinline__ float fsigmoid(float x) { return __builtin_amdgcn_rcpf(1.0f + __expf(-x)); }
__device__ __forceinline__ float fsilu(float x) { return x * fsigmoid(x); }
__device__ __forceinline__ float fgelu_tanh(float x) { return x * fsigmoid(1.5957691216057308f * (x + 0.044715f * x * x * x)); }
__device__ __forceinline__ float wave_sum(float v, int lane) {
#pragma unroll
    for (int o = 32; o >= 1; o >>= 1) v += __uint_as_float((unsigned)__builtin_amdgcn_ds_bpermute((lane ^ o) << 2, (int)__float_as_uint(v)));
    return v;
}
__device__ __forceinline__ void rope_cs(float ang, float& c, float& s) {
    const float k = rintf(ang * 0.15915494309189535f);
    float r = fmaf(-k, 6.28318548202514648f, ang); r = fmaf(-k, -1.74845553e-07f, r);
    const float rev = r * 0.15915494309189535f;
    s = __builtin_amdgcn_sinf(rev); c = __builtin_amdgcn_cosf(rev);
}
__device__ __forceinline__ u32x4 pack8(const float (&e)[8]) { u32x4 w; w.x = cvt_pk_bf16(e[0], e[1]); w.y = cvt_pk_bf16(e[2], e[3]); w.z = cvt_pk_bf16(e[4], e[5]); w.w = cvt_pk_bf16(e[6], e[7]); return w; }
__device__ __forceinline__ void unpack8(u32x4 w, float (&e)[8]) { e[0] = bflo(w.x); e[1] = bfhi(w.x); e[2] = bflo(w.y); e[3] = bfhi(w.y); e[4] = bflo(w.z); e[5] = bfhi(w.z); e[6] = bflo(w.w); e[7] = bfhi(w.w); }

struct WtCtx { LAS float* tile; int gw, nw, lane, base; };
__device__ __forceinline__ void wt_job(WtCtx& c, const float* __restrict__ src, int K, int ldn, int n0, int ncols, bf16_t* __restrict__ dst, int ldd, int drow0, int grp, int gstride, const float* __restrict__ kscale = nullptr) {
    const int tk = K >> 6, tn = ncols >> 5, nt = tk * tn;
    int t = c.gw - c.base; if (t < 0) t += c.nw;
    const int rr = c.lane >> 3, c4 = (c.lane & 7) << 2, ks = c.lane & 7, nn = c.lane >> 3;
    for (; t < nt; t += c.nw) {
        const int nti = t % tn, kti = t / tn, k0 = kti << 6, j0 = nti << 5;
        float4 v[8];
#pragma unroll
        for (int i = 0; i < 8; ++i) v[i] = *(const float4*)(src + (size_t)(k0 + rr + 8 * i) * ldn + n0 + j0 + c4);
#pragma unroll
        for (int i = 0; i < 8; ++i) { LAS float* q = c.tile + (rr + 8 * i) * 33 + c4; q[0] = v[i].x; q[1] = v[i].y; q[2] = v[i].z; q[3] = v[i].w; }
        asm volatile("s_waitcnt lgkmcnt(0)" ::: "memory");
#pragma unroll
        for (int ps = 0; ps < 4; ++ps) {
            const int n = ps * 8 + nn;
            float e[8];
#pragma unroll
            for (int i = 0; i < 8; ++i) e[i] = c.tile[(ks * 8 + i) * 33 + n];
            if (kscale) {
#pragma unroll
                for (int i = 0; i < 8; ++i) e[i] *= kscale[k0 + ks * 8 + i]; }
            const int j = j0 + n, drow = drow0 + (j / grp) * gstride + (j % grp);
            *(u32x4*)(dst + (size_t)drow * ldd + k0 + ks * 8) = pack8(e);
        }
        asm volatile("s_waitcnt lgkmcnt(0)" ::: "memory");
    }
    c.base = (c.base + nt) % c.nw;
}

__device__ __forceinline__ void norm_rows(const float* in, const float* __restrict__ g, bf16_t* __restrict__ out, int gw, int nw, int lane) {
    float4 gv[4];
#pragma unroll
    for (int i = 0; i < 4; ++i) gv[i] = ((const float4*)g)[lane + 64 * i];
    for (int row = gw; row < MT; row += 2 * nw) {
        const int row2 = row + nw; const bool has2 = row2 < MT;
        const float4* p = (const float4*)(in + (size_t)row * DM); const float4* p2 = (const float4*)(in + (size_t)(has2 ? row2 : row) * DM);
        float4 v[4], w2[4];
#pragma unroll
        for (int i = 0; i < 4; ++i) { v[i] = p[lane + 64 * i]; w2[i] = p2[lane + 64 * i]; }
        float ss = 0.f, s2 = 0.f;
#pragma unroll
        for (int i = 0; i < 4; ++i) { ss += v[i].x * v[i].x + v[i].y * v[i].y + v[i].z * v[i].z + v[i].w * v[i].w; s2 += w2[i].x * w2[i].x + w2[i].y * w2[i].y + w2[i].z * w2[i].z + w2[i].w * w2[i].w; }
        ss = wave_sum(ss, lane); s2 = wave_sum(s2, lane);
        const float rs = rsqrtf(ss * (1.0f / 1024.0f) + EPS), rs2 = rsqrtf(s2 * (1.0f / 1024.0f) + EPS);
#pragma unroll
        for (int i = 0; i < 4; ++i) {
            u32x2 w; w.x = cvt_pk_bf16(v[i].x * rs * gv[i].x, v[i].y * rs * gv[i].y); w.y = cvt_pk_bf16(v[i].z * rs * gv[i].z, v[i].w * rs * gv[i].w);
            *(u32x2*)(out + (size_t)row * DM + 4 * (lane + 64 * i)) = w;
            if (has2) { u32x2 y; y.x = cvt_pk_bf16(w2[i].x * rs2 * gv[i].x, w2[i].y * rs2 * gv[i].y); y.y = cvt_pk_bf16(w2[i].z * rs2 * gv[i].z, w2[i].w * rs2 * gv[i].w);
                *(u32x2*)(out + (size_t)row2 * DM + 4 * (lane + 64 * i)) = y; }
        }
    }
}

__device__ __forceinline__ void mid_rows(const Params& p, int gw, int nw, int lane) {
    const bf16_t* cqkr = (const bf16_t*)(p.ws + OFF_F); const bf16_t* ckv = (const bf16_t*)(p.ws + OFF_G);
    bf16_t* cqn = (bf16_t*)(p.ws + OFF_CQN); bf16_t* ckvn = (bf16_t*)(p.ws + OFF_CKVN); bf16_t* kpe = (bf16_t*)(p.ws + OFF_KPE);
    const float* invf = (const float*)(p.ws + OFF_INVF);
    float2 gq[3], gk[2];
#pragma unroll
    for (int i = 0; i < 3; ++i) gq[i] = ((const float2*)p.q_norm)[lane + 64 * i];
#pragma unroll
    for (int i = 0; i < 2; ++i) gk[i] = ((const float2*)p.kv_norm)[lane + 64 * i];
    const float fi = invf[lane & 31];
    for (int row0 = gw; row0 < MT; row0 += 2 * nw) {
        unsigned a[2][3], b[2][2]; float x1[2], x2[2], posf[2]; bool ok[2];
#pragma unroll
        for (int t = 0; t < 2; ++t) {
            const int row = row0 + t * nw; ok[t] = row < MT; const int rr = ok[t] ? row : row0;
            const unsigned* q32 = (const unsigned*)(cqkr + (size_t)rr * 512); const unsigned* k32 = (const unsigned*)(ckv + (size_t)rr * 256);
#pragma unroll
            for (int i = 0; i < 3; ++i) a[t][i] = q32[lane + 64 * i];
#pragma unroll
            for (int i = 0; i < 2; ++i) b[t][i] = k32[lane + 64 * i];
            x1[t] = bf2f(cqkr[(size_t)rr * 512 + 384 + (lane & 31)]); x2[t] = bf2f(cqkr[(size_t)rr * 512 + 416 + (lane & 31)]);
            posf[t] = (float)p.pos[rr];
        }
#pragma unroll
        for (int t = 0; t < 2; ++t) {
            if (!ok[t]) continue;
            const int row = row0 + t * nw;
            float sq = 0.f, sk = 0.f;
#pragma unroll
            for (int i = 0; i < 3; ++i) { const float lo = bflo(a[t][i]), hi = bfhi(a[t][i]); sq += lo * lo + hi * hi; }
#pragma unroll
            for (int i = 0; i < 2; ++i) { const float lo = bflo(b[t][i]), hi = bfhi(b[t][i]); sk += lo * lo + hi * hi; }
            sq = wave_sum(sq, lane); sk = wave_sum(sk, lane);
            const float rq = rsqrtf(sq * (1.0f / 384.0f) + EPS), rk = rsqrtf(sk * (1.0f / 256.0f) + EPS);
            unsigned* oq = (unsigned*)(cqn + (size_t)row * 384); unsigned* ok2 = (unsigned*)(ckvn + (size_t)row * 256);
#pragma unroll
            for (int i = 0; i < 3; ++i) oq[lane + 64 * i] = cvt_pk_bf16(bflo(a[t][i]) * rq * gq[i].x, bfhi(a[t][i]) * rq * gq[i].y);
#pragma unroll
            for (int i = 0; i < 2; ++i) ok2[lane + 64 * i] = cvt_pk_bf16(bflo(b[t][i]) * rk * gk[i].x, bfhi(b[t][i]) * rk * gk[i].y);
            float cs, sn; rope_cs(posf[t] * fi, cs, sn);
            if (lane < 32) { kpe[(size_t)row * 64 + lane] = f2bf(x1[t] * cs - x2[t] * sn); kpe[(size_t)row * 64 + 32 + lane] = f2bf(x2[t] * cs + x1[t] * sn); }
        }
    }
}

__device__ __forceinline__ void final_row_one(const Params& p, const float* gate, const float* pp, int row, int lane, const float4 (&g1)[4], const float4 (&g2)[4], const float4 (&h0)[4], const float4 (&g)[4], const float4 (&q)[4]) {
    float4 h[4];
    float s1 = 0.f;
#pragma unroll
    for (int i = 0; i < 4; ++i) { h[i] = h0[i]; s1 += q[i].x * q[i].x + q[i].y * q[i].y + q[i].z * q[i].z + q[i].w * q[i].w; }
    s1 = wave_sum(s1, lane);
    const float r1 = rsqrtf(s1 * (1.0f / 1024.0f) + EPS);
    float s2 = 0.f;
#pragma unroll
    for (int i = 0; i < 4; ++i) {
        h[i].x += g[i].x * (q[i].x * r1 * g1[i].x); h[i].y += g[i].y * (q[i].y * r1 * g1[i].y); h[i].z += g[i].z * (q[i].z * r1 * g1[i].z); h[i].w += g[i].w * (q[i].w * r1 * g1[i].w);
        s2 += h[i].x * h[i].x + h[i].y * h[i].y + h[i].z * h[i].z + h[i].w * h[i].w;
    }
    s2 = wave_sum(s2, lane);
    const float r2 = rsqrtf(s2 * (1.0f / 1024.0f) + EPS);
    float4* ph = (float4*)(p.out + (size_t)row * DM);
#pragma unroll
    for (int i = 0; i < 4; ++i) { float4 o; o.x = h[i].x * r2 * g2[i].x; o.y = h[i].y * r2 * g2[i].y; o.z = h[i].z * r2 * g2[i].z; o.w = h[i].w * r2 * g2[i].w; ph[lane + 64 * i] = o; }
}
__device__ __forceinline__ void final_rows(const Params& p, int gw, int nw, int lane) {
    const float* gate = (const float*)(p.ws + OFF_B); const float* pp = (const float*)(p.ws + OFF_D);
    float4 g1[4], g2[4];
#pragma unroll
    for (int i = 0; i < 4; ++i) { g1[i] = ((const float4*)p.ple_pn)[lane + 64 * i]; g2[i] = ((const float4*)p.final_norm)[lane + 64 * i]; }
    for (int row = gw; row < MT; row += 2 * nw) {
        const int row2 = row + nw; const bool has2 = row2 < MT; const int rb = has2 ? row2 : row;
        float4 ha[4], ga[4], qa[4], hb[4], gb[4], qb[4];
#pragma unroll
        for (int i = 0; i < 4; ++i) {
            ha[i] = ((const float4*)(p.out + (size_t)row * DM))[lane + 64 * i]; ga[i] = ((const float4*)(gate + (size_t)row * DM))[lane + 64 * i]; qa[i] = ((const float4*)(pp + (size_t)row * DM))[lane + 64 * i];
            hb[i] = ((const float4*)(p.out + (size_t)rb * DM))[lane + 64 * i]; gb[i] = ((const float4*)(gate + (size_t)rb * DM))[lane + 64 * i]; qb[i] = ((const float4*)(pp + (size_t)rb * DM))[lane + 64 * i];
        }
        final_row_one(p, gate, pp, row, lane, g1, g2, ha, ga, qa);
        if (has2) final_row_one(p, gate, pp, row2, lane, g1, g2, hb, gb, qb);
    }
}

template <int ACT> __device__ __forceinline__ void store_bf16_tile(const f32x4 (&acc)[2][2][4][2], bf16_t* O, int ld, int row0, int col0, const float* rs = nullptr) {
#pragma unroll
    for (int ai = 0; ai < 2; ++ai)
#pragma unroll
        for (int m = 0; m < 4; ++m) {
            bf16_t* rowp = O + (size_t)(row0 + ai * 128 + m * 16) * ld + col0;
            const float sc = rs ? rsqrtf(rs[row0 + ai * 128 + m * 16] * (1.0f / 1024.0f) + EPS) : 1.0f;
#pragma unroll
            for (int bj = 0; bj < 2; ++bj) {
                float e[8];
#pragma unroll
                for (int j = 0; j < 4; ++j) { e[j] = acc[ai][bj][m][0][j] * sc; e[4 + j] = acc[ai][bj][m][1][j] * sc; }
                if (ACT == 1) {
#pragma unroll
                    for (int j = 0; j < 8; ++j) e[j] = fgelu_tanh(e[j]);
                }
                if (ACT == 2) {
#pragma unroll
                    for (int j = 0; j < 8; ++j) e[j] = fsigmoid(e[j]);
                }
                *(u32x4*)(rowp + bj * 128) = pack8(e);
            }
        }
}
struct EpiSwiGLU {
    static constexpr bool PERM = true, AFTER_DRAIN = false; bf16_t* O; const float* rs;
    __device__ __forceinline__ void operator()(const f32x4 (&acc)[2][2][4][2], const pg8::Unit& u, int wr, int wc, int fr, int fq) const {
        const int row0 = u.pm * 256 + wr * 64 + fr, col0 = u.pn * 128 + wc * 32 + 8 * fq;
#pragma unroll
        for (int ai = 0; ai < 2; ++ai)
#pragma unroll
            for (int m = 0; m < 4; ++m) {
                const float sc = rs ? rsqrtf(rs[row0 + ai * 128 + m * 16] * (1.0f / 1024.0f) + EPS) : 1.0f;
                float e[8];
#pragma unroll
                for (int j = 0; j < 4; ++j) { e[j] = fsilu(acc[ai][0][m][0][j] * sc) * (acc[ai][1][m][0][j] * sc); e[4 + j] = fsilu(acc[ai][0][m][1][j] * sc) * (acc[ai][1][m][1][j] * sc); }
                *(u32x4*)(O + (size_t)(row0 + ai * 128 + m * 16) * DFF + col0) = pack8(e);
            }
    }
};
struct EpiResid {
    static constexpr bool PERM = false, AFTER_DRAIN = false; const float* base; float* out; bf16_t* hb; float* rs; float alpha; float pad_;
    __device__ __forceinline__ void operator()(const f32x4 (&acc)[2][2][4][2], const pg8::Unit& u, int wr, int wc, int fr, int fq) const {
        const int row0 = u.pm * 256 + wr * 64 + fr, col0 = u.pn * 256 + wc * 32 + 4 * fq;
#pragma unroll
        for (int ai = 0; ai < 2; ++ai)
#pragma unroll
            for (int m = 0; m < 4; ++m) {
                const size_t off = (size_t)(row0 + ai * 128 + m * 16) * DM + col0;
                float ssq = 0.f;
#pragma unroll
                for (int bj = 0; bj < 2; ++bj)
#pragma unroll
                    for (int n = 0; n < 2; ++n) { const f32x4 b = *(const f32x4*)(base + off + bj * 128 + n * 16); const f32x4 h = b + alpha * acc[ai][bj][m][n]; *(f32x4*)(out + off + bj * 128 + n * 16) = h;
                        if (hb) { u32x2 w; w.x = cvt_pk_bf16(h[0], h[1]); w.y = cvt_pk_bf16(h[2], h[3]); *(u32x2*)(hb + off + bj * 128 + n * 16) = w; ssq += h[0] * h[0] + h[1] * h[1] + h[2] * h[2] + h[3] * h[3]; } }
                if (hb) { ssq += __shfl_xor(ssq, 16); ssq += __shfl_xor(ssq, 32); if (fq == 0) (void)__hip_atomic_fetch_add(rs + row0 + ai * 128 + m * 16, ssq, __ATOMIC_RELAXED, __HIP_MEMORY_SCOPE_AGENT); }
            }
    }
};
template <int ACT> struct EpiF32Act {
    static constexpr bool PERM = false, AFTER_DRAIN = false; float* out; const float* rs;
    __device__ __forceinline__ void operator()(const f32x4 (&acc)[2][2][4][2], const pg8::Unit& u, int wr, int wc, int fr, int fq) const {
        const int row0 = u.pm * 256 + wr * 64 + fr, col0 = u.pn * 256 + wc * 32 + 4 * fq;
#pragma unroll
        for (int ai = 0; ai < 2; ++ai)
#pragma unroll
            for (int m = 0; m < 4; ++m) {
                const size_t off = (size_t)(row0 + ai * 128 + m * 16) * DM + col0;
                const float sc = rs ? rsqrtf(rs[row0 + ai * 128 + m * 16] * (1.0f / 1024.0f) + EPS) : 1.0f;
#pragma unroll
                for (int bj = 0; bj < 2; ++bj)
#pragma unroll
                    for (int n = 0; n < 2; ++n) { f32x4 v = acc[ai][bj][m][n] * sc;
                        if (ACT == 1) { v[0] = fsigmoid(v[0]); v[1] = fsigmoid(v[1]); v[2] = fsigmoid(v[2]); v[3] = fsigmoid(v[3]); }
                        *(f32x4*)(out + off + bj * 128 + n * 16) = v; }
            }
    }
};
struct EpiWin {
    static constexpr bool PERM = true, AFTER_DRAIN = false; unsigned char* ws; const float* rs;
    __device__ __forceinline__ void operator()(const f32x4 (&acc)[2][2][4][2], const pg8::Unit& u, int wr, int wc, int fr, int fq) const {
        const int pn = u.pn, row0 = u.pm * 256 + wr * 64 + fr, cw = wc * 32 + 8 * fq;
        if (pn < 4) store_bf16_tile<0>(acc, (bf16_t*)(ws + OFF_B), 1024, row0, 256 * pn + cw, rs);
        else if (pn < 8) store_bf16_tile<1>(acc, (bf16_t*)(ws + OFF_C), 1024, row0, 256 * (pn - 4) + cw, rs);
        else if (pn < 11) { bf16_t* O = (bf16_t*)(ws + (pn == 8 ? OFF_G : OFF_F)); const int ld = pn == 8 ? 256 : 512, c0 = pn == 8 ? 0 : 256 * (pn - 9); store_bf16_tile<0>(acc, O, ld, row0, c0 + cw, rs); }
        else { bf16_t* O = (bf16_t*)(ws + (pn < 15 ? OFF_D : OFF_E)); const int c0 = 256 * (pn < 15 ? pn - 11 : pn - 15); store_bf16_tile<2>(acc, O, 1024, row0, c0 + cw, rs); }
    }
};
struct EpiGateMul {
    static constexpr bool PERM = true, AFTER_DRAIN = false; const bf16_t* G; const bf16_t* T; bf16_t* O; int add;
    __device__ __forceinline__ void operator()(const f32x4 (&acc)[2][2][4][2], const pg8::Unit& u, int wr, int wc, int fr, int fq) const {
        const int row0 = u.pm * 256 + wr * 64 + fr, col0 = u.pn * 256 + wc * 32 + 8 * fq;
#pragma unroll
        for (int ai = 0; ai < 2; ++ai)
#pragma unroll
            for (int m = 0; m < 4; ++m) {
                const size_t off = (size_t)(row0 + ai * 128 + m * 16) * DM + col0;
#pragma unroll
                for (int bj = 0; bj < 2; ++bj) {
                    float g[8], e[8]; unpack8(*(const u32x4*)(G + off + bj * 128), g);
#pragma unroll
                    for (int j = 0; j < 4; ++j) { e[j] = g[j] * acc[ai][bj][m][0][j]; e[4 + j] = g[4 + j] * acc[ai][bj][m][1][j]; }
                    if (add) { float t[8]; unpack8(*(const u32x4*)(T + off + bj * 128), t);
#pragma unroll
                        for (int j = 0; j < 8; ++j) e[j] += t[j]; }
                    *(u32x4*)(O + off + bj * 128) = pack8(e);
                }
            }
    }
};
struct EpiQ {
    static constexpr bool PERM = true, AFTER_DRAIN = false; bf16_t* Qn; bf16_t* Qr;
    __device__ __forceinline__ void operator()(const f32x4 (&acc)[2][2][4][2], const pg8::Unit& u, int wr, int wc, int fr, int fq) const {
        const int row0 = u.pm * 256 + wr * 64 + fr;
        if (u.pn < 4) { store_bf16_tile<0>(acc, Qn, 1024, row0, 256 * u.pn + wc * 32 + 8 * fq); return; }
        const int head = 4 * (u.pn - 4) + wc;
#pragma unroll
        for (int ai = 0; ai < 2; ++ai)
#pragma unroll
            for (int m = 0; m < 4; ++m) {
                bf16_t* dst = Qr + (size_t)(row0 + ai * 128 + m * 16) * 512 + 64 * head + 8 * fq;
                float e[8];
#pragma unroll
                for (int j = 0; j < 4; ++j) { e[j] = acc[ai][0][m][0][j]; e[4 + j] = acc[ai][0][m][1][j]; }
                *(u32x4*)dst = pack8(e);
#pragma unroll
                for (int j = 0; j < 4; ++j) { e[j] = acc[ai][1][m][0][j]; e[4 + j] = acc[ai][1][m][1][j]; }
                *(u32x4*)(dst + 32) = pack8(e);
            }
    }
};
struct EpiKV {
    static constexpr bool PERM = true, AFTER_DRAIN = false; bf16_t* Kn; bf16_t* V;
    __device__ __forceinline__ void operator()(const f32x4 (&acc)[2][2][4][2], const pg8::Unit& u, int wr, int wc, int fr, int fq) const {
        const int row0 = u.pm * 256 + wr * 64 + fr, col0 = u.pn * 128 + wc * 32 + 8 * fq;
#pragma unroll
        for (int ai = 0; ai < 2; ++ai)
#pragma unroll
            for (int m = 0; m < 4; ++m) {
                const size_t off = (size_t)(row0 + ai * 128 + m * 16) * DM + col0;
                float e[8];
#pragma unroll
                for (int j = 0; j < 4; ++j) { e[j] = acc[ai][0][m][0][j]; e[4 + j] = acc[ai][0][m][1][j]; }
                *(u32x4*)(Kn + off) = pack8(e);
#pragma unroll
                for (int j = 0; j < 4; ++j) { e[j] = acc[ai][1][m][0][j]; e[4 + j] = acc[ai][1][m][1][j]; }
                *(u32x4*)(V + off) = pack8(e);
            }
    }
};

constexpr int LRU_XS = 272;
constexpr int LRU_AP = 132;
template <bool FINAL>
__device__ __forceinline__ void lru_phase(const Params& p, LAS unsigned char* lds, int bid, int G) {
    int tid_ = threadIdx.x; asm volatile("" : "+v"(tid_));
    const int tid = tid_, wid = tid >> 6, lane = tid & 63, fr = lane & 15, fq = lane >> 4;
    LAS unsigned char* Xs = lds;
    LAS float* AF = (LAS float*)(lds + 64 * LRU_XS);
    LAS float* UF = AF + 64 * LRU_AP; LAS float* AB = UF + 64 * LRU_AP; LAS float* UB = AB + 64 * LRU_AP;
    const bf16_t* zx = (const bf16_t*)(p.ws + OFF_B); const bf16_t* zg = (const bf16_t*)(p.ws + OFF_C); bf16_t* yA = (bf16_t*)(p.ws + OFF_A);
    float* carP = (float*)(p.ws + OFF_CARP); float* carH = (float*)(p.ws + OFF_CARH);
    const bf16_t* WG = (const bf16_t*)p.ws + EWG;
    bf16x8 Bf[4][4]; float brf = 0.f, bif = 0.f, brb = 0.f, bib = 0.f, spf = 0.f, spb = 0.f; int blk_have = -1;
    for (int item = bid; item < 4096; item += G) {
        const int blk = item & 7, c = (item >> 3) & 63, b = item >> 9;
        const int t0 = c * 64; const size_t rowbase = (size_t)b * SEQ;
        if (blk != blk_have) {
            blk_have = blk;
            const bf16_t* wb = WG + (size_t)blk * 65536 + (size_t)(wid * 16 + fr) * 128 + fq * 8;
#pragma unroll
            for (int g = 0; g < 4; ++g)
#pragma unroll
                for (int ks = 0; ks < 4; ++ks) Bf[g][ks] = *(const bf16x8*)(wb + (size_t)g * 16384 + ks * 32);
            const int cgc = blk * 128 + wid * 16 + fr;
            brf = p.lru_br[cgc]; bif = p.lru_bi[cgc]; brb = p.lru_br[1024 + cgc]; bib = p.lru_bi[1024 + cgc];
            spf = 8.0f * log1pf(expf(-p.lru_lam[cgc])); spb = 8.0f * log1pf(expf(-p.lru_lam[1024 + cgc]));
        }
        float hin = 0.f;
        if (FINAL) {
            for (int i = tid; i < 4096; i += 512) {
                const int d = i >> 11, cc = (i >> 5) & 63, q4 = i & 31;
                const size_t gofs = ((size_t)(b * 2 + d) * 64 + cc) * 1024 + blk * 128 + q4 * 4;
                const f32x4 pv = *(const f32x4*)(carP + gofs), hv = *(const f32x4*)(carH + gofs);
                *(LAS f32x4*)((d ? AB : AF) + cc * LRU_AP + q4 * 4) = pv; *(LAS f32x4*)((d ? UB : UF) + cc * LRU_AP + q4 * 4) = hv;
            }
            __syncthreads();
            if (tid < 256) {
                const int dir = tid >> 7, ch = tid & 127;
                const LAS float* Pp = dir ? AB : AF; const LAS float* Hh = dir ? UB : UF;
                if (dir == 0) {
#pragma unroll 16
                    for (int c2 = 0; c2 < 64; ++c2) { const float pv = Pp[c2 * LRU_AP + ch], hv = Hh[c2 * LRU_AP + ch]; hin = (c2 < c) ? pv * hin + hv : hin; }
                } else {
#pragma unroll 16
                    for (int c2 = 63; c2 >= 0; --c2) { const float pv = Pp[c2 * LRU_AP + ch], hv = Hh[c2 * LRU_AP + ch]; hin = (c2 > c) ? pv * hin + hv : hin; }
                }
            }
            __syncthreads();
        }
        { const int tok = tid >> 3, cs = tid & 7, cg0 = blk * 128 + cs * 16;
          float y[16];
#pragma unroll
          for (int q = 0; q < 4; ++q) { const float4 bv = *(const float4*)(p.conv_b + cg0 + 4 * q); y[4 * q] = bv.x; y[4 * q + 1] = bv.y; y[4 * q + 2] = bv.z; y[4 * q + 3] = bv.w; }
#pragma unroll
          for (int k = 0; k < 4; ++k) {
              const int t = t0 + tok + k - 2;
              if (t >= 0 && t < SEQ) {
                  const u32x4* zp = (const u32x4*)(zx + (rowbase + t) * DM + cg0);
                  float z[16]; { float e[8]; unpack8(zp[0], e);
#pragma unroll
                      for (int j = 0; j < 8; ++j) z[j] = e[j];
                      unpack8(zp[1], e);
#pragma unroll
                      for (int j = 0; j < 8; ++j) z[8 + j] = e[j]; }
#pragma unroll
                  for (int q = 0; q < 4; ++q) { const float4 wv = *(const float4*)(p.conv_w + k * 1024 + cg0 + 4 * q);
                      y[4 * q] += wv.x * z[4 * q]; y[4 * q + 1] += wv.y * z[4 * q + 1]; y[4 * q + 2] += wv.z * z[4 * q + 2]; y[4 * q + 3] += wv.w * z[4 * q + 3]; }
              }
          }
          float e0[8], e1[8];
#pragma unroll
          for (int j = 0; j < 8; ++j) { e0[j] = y[j]; e1[j] = y[8 + j]; }
          LAS u32x4* xd = (LAS u32x4*)(Xs + tok * LRU_XS + cs * 32);
          xd[0] = pack8(e0); xd[1] = pack8(e1);
        }
        __syncthreads();
        { const int ch = wid * 16 + fr;
#pragma unroll
          for (int m = 0; m < 4; ++m) {
              bf16x8 Af[4];
#pragma unroll
              for (int ks = 0; ks < 4; ++ks) Af[ks] = *(const LAS bf16x8*)(Xs + (16 * m + fr) * LRU_XS + (ks * 32 + fq * 8) * 2);
              f32x4 acc[4];
#pragma unroll
              for (int g = 0; g < 4; ++g) { acc[g] = (f32x4){0.f, 0.f, 0.f, 0.f};
#pragma unroll
                  for (int ks = 0; ks < 4; ++ks) acc[g] = __builtin_amdgcn_mfma_f32_16x16x32_bf16(Af[ks], Bf[g][ks], acc[g], 0, 0, 0); }
#pragma unroll
              for (int j = 0; j < 4; ++j) {
                  const int tok = 16 * m + 4 * fq + j;
                  const float x = bf2f(*(const LAS bf16_t*)(Xs + tok * LRU_XS + ch * 2));
#pragma unroll
                  for (int d = 0; d < 2; ++d) {
                      const float r = fsigmoid(acc[2 * d][j] + (d ? brb : brf)), gi = fsigmoid(acc[2 * d + 1][j] + (d ? bib : bif));
                      const float la = -r * (d ? spb : spf);
                      const float a = __expf(la);
                      const float e2 = 2.0f * la;
                      const float om = (e2 > -0.125f) ? -e2 * (1.0f + e2 * (0.5f + e2 * (0.16666667f + e2 * (0.041666668f + e2 * 0.0083333338f)))) : 1.0f - a * a;
                      const float uu = __builtin_amdgcn_sqrtf(om) * (gi * x);
                      (d ? AB : AF)[tok * LRU_AP + ch] = a; (d ? UB : UF)[tok * LRU_AP + ch] = uu;
                  }
              }
          }
        }
        __syncthreads();
        if (tid < 256) {
            const int dir = tid >> 7, ch = tid & 127, cgl = blk * 128 + ch;
            LAS float* Aa = dir ? AB : AF; LAS float* Uu = dir ? UB : UF;
            const size_t cb = ((size_t)(b * 2 + dir) * 64) * 1024 + cgl;
            float h = hin, P = 1.f;
            if (dir == 0) {
#pragma unroll 8
                for (int t = 0; t < 64; ++t) { const float a = Aa[t * LRU_AP + ch], uu = Uu[t * LRU_AP + ch]; h = a * h + uu; if (FINAL) Uu[t * LRU_AP + ch] = h; else P *= a; }
            } else {
#pragma unroll 8
                for (int t = 63; t >= 0; --t) { const float a = Aa[t * LRU_AP + ch], uu = Uu[t * LRU_AP + ch]; h = a * h + uu; if (FINAL) Uu[t * LRU_AP + ch] = h; else P *= a; }
            }
            if (!FINAL) { carP[cb + (size_t)c * 1024] = P; carH[cb + (size_t)c * 1024] = h; }
        }
        if (FINAL) {
            __syncthreads();
            const int tok = tid >> 3, cs = tid & 7, cg0 = blk * 128 + cs * 16; const size_t row = rowbase + t0 + tok;
            const u32x4* gp = (const u32x4*)(zg + row * DM + cg0);
            u32x4* yp = (u32x4*)(yA + row * DM + cg0);
#pragma unroll
            for (int hh = 0; hh < 2; ++hh) {
                float g[8], e[8]; unpack8(gp[hh], g);
                const f32x4 f0 = *(const LAS f32x4*)(UF + tok * LRU_AP + cs * 16 + hh * 8), f1 = *(const LAS f32x4*)(UF + tok * LRU_AP + cs * 16 + hh * 8 + 4);
                const f32x4 b0 = *(const LAS f32x4*)(UB + tok * LRU_AP + cs * 16 + hh * 8), b1 = *(const LAS f32x4*)(UB + tok * LRU_AP + cs * 16 + hh * 8 + 4);
#pragma unroll
                for (int j = 0; j < 4; ++j) { e[j] = (f0[j] + b0[j]) * g[j]; e[4 + j] = (f1[j] + b1[j]) * g[4 + j]; }
                yp[hh] = pack8(e);
            }
        }
    }
    __syncthreads();
}

namespace att {
constexpr int KVBLK = 64;
constexpr float SCALE = 0.07216878364870322f;
constexpr float THR = 8.f;
#ifndef ATT_SDEPTH
#define ATT_SDEPTH 1
#endif
constexpr int SDEPTH = ATT_SDEPTH;
constexpr int SHM_V = 64 * 128 * 2, SHM_K = 64 * 192 * 2;
#define ATT_KSWZ(row, colB) ((row) * 384 + ((colB) ^ (((row) & 7) << 4)))
#define ATT_SBAR() __builtin_amdgcn_sched_barrier(0)
__device__ __forceinline__ int crow(int r, int hi) { return (r & 3) + 8 * (r >> 2) + 4 * hi; }
__device__ __forceinline__ void partialSM(f32x16& p0, f32x16& p1, float& m_reg, float& mn, float& alpha) {
    constexpr float C = SCALE * 1.4426950408889634f;
    float pmax = p0[0];
#pragma unroll
    for (int r = 1; r < 16; ++r) pmax = fmaxf(pmax, p0[r]);
#pragma unroll
    for (int r = 0; r < 16; ++r) pmax = fmaxf(pmax, p1[r]);
    { auto rr = __builtin_amdgcn_permlane32_swap(__float_as_uint(pmax), __float_as_uint(pmax), false, false);
      pmax = fmaxf(__uint_as_float(rr[0]), __uint_as_float(rr[1])); }
    if (__builtin_expect(__all(pmax - m_reg <= THR / SCALE), 1)) { mn = m_reg; alpha = 1.f; }
    else { mn = fmaxf(m_reg, pmax); alpha = __builtin_amdgcn_exp2f((m_reg - mn) * C); m_reg = mn; }
    const float mnC = -mn * C;
#pragma unroll
    for (int r = 0; r < 16; ++r) p0[r] = fmaf(p0[r], C, mnC);
#pragma unroll
    for (int r = 0; r < 16; ++r) p1[r] = fmaf(p1[r], C, mnC);
#pragma unroll
    for (int r = 0; r < 16; ++r) p0[r] = __builtin_amdgcn_exp2f(p0[r]);
}
__device__ __forceinline__ void finishSM(f32x16& p0, f32x16& p1, float alpha, float& l_reg, bf16x8& pa0, bf16x8& pa1, bf16x8& pa2, bf16x8& pa3) {
#pragma unroll
    for (int r = 0; r < 16; ++r) p1[r] = __builtin_amdgcn_exp2f(p1[r]);
    float ps = 0;
#pragma unroll
    for (int r = 0; r < 16; ++r) ps += p0[r];
#pragma unroll
    for (int r = 0; r < 16; ++r) ps += p1[r];
    { auto rr = __builtin_amdgcn_permlane32_swap(__float_as_uint(ps), __float_as_uint(ps), false, false);
      ps = __uint_as_float(rr[0]) + __uint_as_float(rr[1]); }
    l_reg = l_reg * alpha + ps;
#define ATT_PK4(P, BASE, OUT) do { unsigned a0 = cvt_pk_bf16(P[BASE + 0], P[BASE + 1]), a1 = cvt_pk_bf16(P[BASE + 2], P[BASE + 3]);   \
    unsigned b0 = cvt_pk_bf16(P[BASE + 4], P[BASE + 5]), b1 = cvt_pk_bf16(P[BASE + 6], P[BASE + 7]);                              \
    auto r0 = __builtin_amdgcn_permlane32_swap(a0, b0, false, false); auto r1 = __builtin_amdgcn_permlane32_swap(a1, b1, false, false); \
    u32x4 w = {r0[0], r1[0], r0[1], r1[1]}; OUT = *reinterpret_cast<bf16x8*>(&w); } while (0)
    ATT_PK4(p0, 0, pa0); ATT_PK4(p0, 8, pa1); ATT_PK4(p1, 0, pa2); ATT_PK4(p1, 8, pa3);
#undef ATT_PK4
}
__device__ __forceinline__ void qkt(f32x16& p0, f32x16& p1, const char* Ks, const bf16x8* qr, int r32, int hi) {
    p0 = f32x16{}; p1 = f32x16{};
#pragma unroll
    for (int d0 = 0; d0 < 12; ++d0) { const int cb = (d0 * 16 + hi * 8) * 2;
        const bf16x8 b0 = *reinterpret_cast<const bf16x8*>(Ks + ATT_KSWZ(r32, cb));
        const bf16x8 b1 = *reinterpret_cast<const bf16x8*>(Ks + ATT_KSWZ(32 + r32, cb));
        p0 = __builtin_amdgcn_mfma_f32_32x32x16_bf16(b0, qr[d0], p0, 0, 0, 0);
        p1 = __builtin_amdgcn_mfma_f32_32x32x16_bf16(b1, qr[d0], p1, 0, 0, 0); }
}
__device__ __forceinline__ int v_st(int k, int c) { const int kk = (k & ~0xC) | ((k & 4) << 1) | ((k & 8) >> 1); return ((kk >> 3) * 4 + (c >> 5)) * 512 + ((kk & 7) * 32 + (c & 31)) * 2; }
__device__ __forceinline__ int v_rd_base(int lane) { return ((lane & 3) << 3) | (((lane >> 2) & 3) << 6) | (((lane >> 4) & 1) << 5) | (((lane >> 5) & 1) << 8); }
constexpr int v_rd_off(int d0, int ks, int half) { return d0 * 512 + ks * 4096 + half * 2048; }
template <int OFF> __device__ __forceinline__ s16x4 tr_read(int vb) {
    s16x4 r; asm volatile("ds_read_b64_tr_b16 %0, %1 offset:%2" : "=&v"(r) : "v"(vb), "i"(OFF) : "memory"); return r;
}
template <int D0> __device__ __forceinline__ void pv_one(f32x16& od, int vb, bf16x8 pa0, bf16x8 pa1, bf16x8 pa2, bf16x8 pa3) {
    const s16x4 l0 = tr_read<v_rd_off(D0, 0, 0)>(vb), h0 = tr_read<v_rd_off(D0, 0, 1)>(vb), l1 = tr_read<v_rd_off(D0, 1, 0)>(vb), h1 = tr_read<v_rd_off(D0, 1, 1)>(vb);
    const s16x4 l2 = tr_read<v_rd_off(D0, 2, 0)>(vb), h2 = tr_read<v_rd_off(D0, 2, 1)>(vb), l3 = tr_read<v_rd_off(D0, 3, 0)>(vb), h3 = tr_read<v_rd_off(D0, 3, 1)>(vb);
    asm volatile("s_waitcnt lgkmcnt(0)" ::: "memory"); ATT_SBAR();
#define ATT_PK(L, H) (bf16x8){L[0], L[1], L[2], L[3], H[0], H[1], H[2], H[3]}
    od = __builtin_amdgcn_mfma_f32_32x32x16_bf16(pa0, ATT_PK(l0, h0), od, 0, 0, 0);
    od = __builtin_amdgcn_mfma_f32_32x32x16_bf16(pa1, ATT_PK(l1, h1), od, 0, 0, 0);
    od = __builtin_amdgcn_mfma_f32_32x32x16_bf16(pa2, ATT_PK(l2, h2), od, 0, 0, 0);
    od = __builtin_amdgcn_mfma_f32_32x32x16_bf16(pa3, ATT_PK(l3, h3), od, 0, 0, 0);
#undef ATT_PK
}
__device__ __forceinline__ void pv_d0(f32x16* o, int vb, bf16x8 pa0, bf16x8 pa1, bf16x8 pa2, bf16x8 pa3) {
    pv_one<0>(o[0], vb, pa0, pa1, pa2, pa3); pv_one<1>(o[1], vb, pa0, pa1, pa2, pa3); pv_one<2>(o[2], vb, pa0, pa1, pa2, pa3); pv_one<3>(o[3], vb, pa0, pa1, pa2, pa3);
}
__device__ __forceinline__ void body(const bf16_t* Qn, const bf16_t* Qr, const bf16_t* __restrict__ Kh, const bf16_t* __restrict__ Vh, const bf16_t* __restrict__ Kp, bf16_t* Ob, const int* __restrict__ posq, const float* __restrict__ invf, char* lds) {
    int tid_ = threadIdx.x; asm volatile("" : "+v"(tid_));
    const int tid = tid_, wid = tid >> 6, lane = tid & 63, r32 = lane & 31, hi = lane >> 5;
    char* V_lds = lds; char* K_lds = lds + 2 * SHM_V;
    float* ws = (float*)(lds + 2 * SHM_V + 2 * SHM_K) + wid * 64; float* li_l = ws; float* al_l = ws + 32;
    float m_reg = -1e30f, l_reg = 0; f32x16 o[4] = {}; bf16x8 qr[12];
    { const bf16_t* qa = Qn + (size_t)(wid * 32 + r32) * 1024 + hi * 8; const bf16_t* qb = Qr + (size_t)(wid * 32 + r32) * 512 + hi * 8;
#pragma unroll
      for (int d0 = 0; d0 < 8; ++d0) qr[d0] = *reinterpret_cast<const bf16x8*>(qa + d0 * 16);
#pragma unroll
      for (int d0 = 0; d0 < 4; ++d0) qr[8 + d0] = *reinterpret_cast<const bf16x8*>(qb + d0 * 16); }
    {
        const float posf = (float)posq[wid * 32 + r32];
#pragma unroll
        for (int t = 0; t < 2; ++t) {
            const f32x4 fa = *(const f32x4*)(invf + 16 * t + 8 * hi), fb = *(const f32x4*)(invf + 16 * t + 8 * hi + 4);
            float x1[8], x2[8], o1[8], o2[8];
            unpack8(*reinterpret_cast<const u32x4*>(&qr[8 + t]), x1); unpack8(*reinterpret_cast<const u32x4*>(&qr[10 + t]), x2);
#pragma unroll
            for (int j = 0; j < 8; ++j) { float cs, sn; rope_cs(posf * (j < 4 ? fa[j] : fb[j - 4]), cs, sn); o1[j] = x1[j] * cs - x2[j] * sn; o2[j] = x2[j] * cs + x1[j] * sn; }
            const u32x4 w1 = pack8(o1), w2 = pack8(o2);
            qr[8 + t] = *reinterpret_cast<const bf16x8*>(&w1); qr[10 + t] = *reinterpret_cast<const bf16x8*>(&w2);
        }
    }
    const int sr = tid >> 4, sc = (tid & 15) * 8, vst0 = v_st(sr, sc), vst1 = v_st(32 + sr, sc);
    const int pr = tid >> 3, pc = (tid & 7) * 8;
    const int vb0 = (int)(uintptr_t)V_lds + v_rd_base(lane);
    struct { bf16x8 vs0, vs1, ks0, ks1, kp; } sr_[SDEPTH];
#define ATT_SLOAD(i, k0) do { sr_[i].vs0 = *(const bf16x8*)(&Vh[(size_t)((k0) + sr) * 1024 + sc]); sr_[i].vs1 = *(const bf16x8*)(&Vh[(size_t)((k0) + 32 + sr) * 1024 + sc]); \
    sr_[i].ks0 = *(const bf16x8*)(&Kh[(size_t)((k0) + sr) * 1024 + sc]); sr_[i].ks1 = *(const bf16x8*)(&Kh[(size_t)((k0) + 32 + sr) * 1024 + sc]); \
    sr_[i].kp = *(const bf16x8*)(&Kp[(size_t)((k0) + pr) * 64 + pc]); } while (0)
#define ATT_SWRITE(b, i) do { *(bf16x8*)(V_lds + (b) * SHM_V + vst0) = sr_[i].vs0; *(bf16x8*)(V_lds + (b) * SHM_V + vst1) = sr_[i].vs1; const int kc = sc * 2; \
    *(bf16x8*)(K_lds + (b) * SHM_K + ATT_KSWZ(sr, kc)) = sr_[i].ks0; *(bf16x8*)(K_lds + (b) * SHM_K + ATT_KSWZ(32 + sr, kc)) = sr_[i].ks1; \
    *(bf16x8*)(K_lds + (b) * SHM_K + ATT_KSWZ(pr, 256 + pc * 2)) = sr_[i].kp; } while (0)
#define ATT_SWAIT() do { if constexpr (SDEPTH == 2) asm volatile("s_waitcnt vmcnt(5)" ::: "memory"); else asm volatile("s_waitcnt vmcnt(0)" ::: "memory"); } while (0)
#define ATT_RESC(a) do { if (__any((a) < 1.f)) { if (hi == 0) al_l[r32] = (a); asm volatile("s_waitcnt lgkmcnt(0)" ::: "memory"); \
    _Pragma("unroll") for (int d = 0; d < 4; ++d) _Pragma("unroll") for (int r = 0; r < 16; ++r) o[d][r] *= al_l[crow(r, hi)]; } } while (0)
    f32x16 pA0, pA1, pB0, pB1; float mnA, mnB, alA, alB; bf16x8 pa0, pa1, pa2, pa3; constexpr int NT = SEQ / KVBLK;
    constexpr int SE = 0, SO = SDEPTH - 1;
    ATT_SLOAD(SE, 0); asm volatile("s_waitcnt vmcnt(0)" ::: "memory"); ATT_SWRITE(0, SE); __syncthreads();
    qkt(pA0, pA1, K_lds, qr, r32, hi); partialSM(pA0, pA1, m_reg, mnA, alA);
    ATT_SLOAD(SO, KVBLK); if constexpr (SDEPTH == 2) ATT_SLOAD(SE, 2 * KVBLK);
    ATT_SWAIT(); ATT_SWRITE(1, SO); __syncthreads();
    for (int j = 1; j + 1 < NT; j += 2) {
        ATT_SBAR(); qkt(pB0, pB1, K_lds + SHM_K, qr, r32, hi);
        finishSM(pA0, pA1, alA, l_reg, pa0, pa1, pa2, pa3); ATT_SBAR();
        ATT_SLOAD(SO, (j + SDEPTH) * KVBLK); ATT_SBAR();
        pv_d0(o, vb0, pa0, pa1, pa2, pa3); partialSM(pB0, pB1, m_reg, mnB, alB);
        __syncthreads(); ATT_SWAIT(); ATT_SWRITE(0, SE);
        ATT_RESC(alB); __syncthreads();
        ATT_SBAR(); qkt(pA0, pA1, K_lds, qr, r32, hi);
        finishSM(pB0, pB1, alB, l_reg, pa0, pa1, pa2, pa3); ATT_SBAR();
        if (SDEPTH == 1 || j + 3 < NT) ATT_SLOAD(SE, (j + 1 + SDEPTH) * KVBLK); ATT_SBAR();
        pv_d0(o, vb0 + SHM_V, pa0, pa1, pa2, pa3); partialSM(pA0, pA1, m_reg, mnA, alA);
        __syncthreads(); ATT_SWAIT(); ATT_SWRITE(1, SO);
        ATT_RESC(alA); __syncthreads();
    }
    ATT_SBAR(); qkt(pB0, pB1, K_lds + SHM_K, qr, r32, hi);
    finishSM(pA0, pA1, alA, l_reg, pa0, pa1, pa2, pa3); ATT_SBAR();
    pv_d0(o, vb0, pa0, pa1, pa2, pa3); partialSM(pB0, pB1, m_reg, mnB, alB);
    __syncthreads(); ATT_RESC(alB);
    finishSM(pB0, pB1, alB, l_reg, pa0, pa1, pa2, pa3); ATT_SBAR();
    pv_d0(o, vb0 + SHM_V, pa0, pa1, pa2, pa3);
    if (hi == 0) li_l[r32] = l_reg; asm volatile("s_waitcnt lgkmcnt(0)" ::: "memory");
    float rli[16];
#pragma unroll
    for (int r = 0; r < 16; ++r) rli[r] = __builtin_amdgcn_rcpf(li_l[crow(r, hi)]);
    bf16_t* Ow = Ob + (size_t)(wid * 32) * 1024;
#pragma unroll
    for (int r = 0; r < 16; ++r) { const int orow = crow(r, hi);
#pragma unroll
        for (int d0 = 0; d0 < 4; ++d0) Ow[(size_t)orow * 1024 + d0 * 32 + r32] = f2bf(o[d0][r] * rli[r]); }
#undef ATT_SLOAD
#undef ATT_SWRITE
#undef ATT_SWAIT
#undef ATT_RESC
}
}

__device__ __forceinline__ void attn_phase(const Params& p, char* smem, int bid, int G) {
    bf16_t* Qn = (bf16_t*)(p.ws + OFF_A); const bf16_t* Qr = (const bf16_t*)(p.ws + OFF_QR);
    const bf16_t* Kn = (const bf16_t*)(p.ws + OFF_C); const bf16_t* V = (const bf16_t*)(p.ws + OFF_D); const bf16_t* Kp = (const bf16_t*)(p.ws + OFF_KPE);
    for (int u = bid; u < 1024; u += G) {
        const int qb = u & 15, h = (u >> 4) & 7, b = u >> 7;
        const size_t r0 = (size_t)b * SEQ, q0 = r0 + (size_t)qb * 256;
        __syncthreads();
        att::body(Qn + q0 * 1024 + 128 * h, Qr + q0 * 512 + 64 * h, Kn + r0 * 1024 + 128 * h, V + r0 * 1024 + 128 * h, Kp + r0 * 64, Qn + q0 * 1024 + 128 * h, p.pos + q0, (const float*)(p.ws + OFF_INVF), smem);
    }
    __syncthreads();
}

__device__ __forceinline__ void phase_prep(const Params& p, LAS unsigned char* lds, int gw, int nw, int wid, int lane) {
    bf16_t* W = (bf16_t*)p.ws;
    WtCtx c{(LAS float*)(lds + wid * 8448), gw, nw, lane, 0};
#pragma unroll 1
    for (int f = 0; f < 2; ++f) {
        const float* wg = f ? p.ffn2_wg : p.ffn1_wg; const float* wu = f ? p.ffn2_wu : p.ffn1_wu; const float* wd = f ? p.ffn2_wd : p.ffn1_wd;
        bf16_t* gu = W + (f ? EW2GU : EW1GU); bf16_t* dn = W + (f ? EW2D : EW1D);
        const float* ks = f ? p.ffn2_norm : nullptr;
        wt_job(c, wg, 1024, 2816, 0, 2816, gu, 1024, 0, 128, 256, ks);
        wt_job(c, wu, 1024, 2816, 0, 2816, gu, 1024, 128, 128, 256, ks);
        wt_job(c, wd, 2816, 1024, 0, 1024, dn, 2816, 0, 1024, 0);
    }
    { bf16_t* Win = W + EWIN;
      wt_job(c, p.w_in, 1024, 4800, 0, 1024, Win, 1024, 0, 1024, 0, p.mix_norm);
      wt_job(c, p.w_in, 1024, 4800, 1024, 1024, Win, 1024, 1024, 1024, 0, p.mix_norm);
      wt_job(c, p.w_in, 1024, 4800, 2432, 256, Win, 1024, 2048, 256, 0, p.mix_norm);
      wt_job(c, p.w_in, 1024, 4800, 2048, 384, Win, 1024, 2304, 384, 0, p.mix_norm);
      wt_job(c, p.w_in, 1024, 4800, 2688, 64, Win, 1024, 2688, 64, 0, p.mix_norm);
      wt_job(c, p.w_in, 1024, 4800, 2752, 1024, Win, 1024, 2816, 1024, 0, p.mix_norm);
      wt_job(c, p.w_in, 1024, 4800, 3776, 1024, Win, 1024, 3840, 1024, 0, p.mix_norm);
      const int gt = gw * 64 + lane;
      for (int i = gt; i < 8192; i += nw * 64) ((u32x4*)(Win + 2752 * 1024))[i] = (u32x4){0u, 0u, 0u, 0u};
    }
#pragma unroll 1
    for (int db = 0; db < 16; ++db) {
        const int dir = db >> 3, blk = db & 7;
        wt_job(c, p.lru_wr + (size_t)db * 16384, 128, 128, 0, 128, W + EWG + (size_t)blk * 65536, 128, dir * 256, 128, 0);
        wt_job(c, p.lru_wi + (size_t)db * 16384, 128, 128, 0, 128, W + EWG + (size_t)blk * 65536, 128, dir * 256 + 128, 128, 0);
    }
#pragma unroll 1
    for (int h = 0; h < 8; ++h) {
        wt_job(c, p.w_uq, 384, 1536, 192 * h, 128, W + EWUQ, 384, 128 * h, 128, 0);
        wt_job(c, p.w_uq, 384, 1536, 192 * h + 128, 32, W + EWUQ, 384, 1024 + 256 * (h >> 2) + 32 * (h & 3), 32, 0);
        wt_job(c, p.w_uq, 384, 1536, 192 * h + 160, 32, W + EWUQ, 384, 1024 + 256 * (h >> 2) + 128 + 32 * (h & 3), 32, 0);
    }
    wt_job(c, p.w_ukv, 256, 2048, 0, 2048, W + EWUKV, 256, 0, 2048, 0);
    wt_job(c, p.w_lru_out, 1024, 1024, 0, 1024, W + EWLO, 1024, 0, 1024, 0);
    wt_job(c, p.w_mla_out, 1024, 1024, 0, 1024, W + EWMO, 1024, 0, 1024, 0);
    wt_job(c, p.w_o, 1024, 1024, 0, 1024, W + EWO, 1024, 0, 1024, 0);
    wt_job(c, p.ple_wg, 1024, 1024, 0, 1024, W + EWPG, 1024, 0, 1024, 0, p.ple_norm);
    wt_job(c, p.ple_wp, 256, 1024, 0, 1024, W + EWPP, 256, 0, 1024, 0);
    if (gw == 0 && lane == 0) { float* t = (float*)(p.ws + OFF_INVF);
#pragma unroll
        for (int i = 0; i < 32; ++i) t[i] = p.inv_freq[i]; }
    { float* rs = (float*)(p.ws + OFF_RS); for (int i = gw * 64 + lane; i < 3 * MT; i += nw * 64) rs[i] = 0.f; }
    norm_rows(p.x, p.ffn1_norm, (bf16_t*)(p.ws + OFF_A), gw, nw, lane);
}

template <class Epi> __device__ __forceinline__ void run_gemm(LAS unsigned char* lds, const bf16_t* A, const bf16_t* Bt, int N, int K, const Epi E, int bid, int G) {
    pg8::Gemm g{A, Bt, MT, N, K}; pg8::StaticOrder S; S.init(MT, N, G, bid);
    pg8::gemm_phase<Epi, pg8::StaticOrder, false>(lds, g, S, E, nullptr);
}

__device__ __forceinline__ void run_phase(const Params& p, int ph, unsigned char* smem) {
    LAS unsigned char* lds = (LAS unsigned char*)smem;
    int tid_ = threadIdx.x; asm volatile("" : "+v"(tid_));
    int bid = blockIdx.x, G = gridDim.x; asm volatile("" : "+s"(bid), "+s"(G));
    const int tid = tid_, wid = tid >> 6, lane = tid & 63, nw = G * 8, gw = bid * 8 + wid;
    unsigned char* ws = p.ws; const bf16_t* W = (const bf16_t*)ws;
    bf16_t* bA = (bf16_t*)(ws + OFF_A); bf16_t* bD = (bf16_t*)(ws + OFF_D);
#ifndef PH_MASK
#define PH_MASK 0x3ffff
#endif
#define PH_ON(k) constexpr (((PH_MASK) >> (k)) & 1)
    switch (ph) {
    case 0: if PH_ON(0) phase_prep(p, lds, gw, nw, wid, lane); break;
    case 1: case 13: if PH_ON(1) {
        if (ph == 13) { bf16_t* pb = (bf16_t*)(ws + OFF_F);
            for (int i = gw * 64 + lane; i < MT * 256 / 8; i += 2 * nw * 64) {
                const int i2 = i + nw * 64; const bool h2 = i2 < MT * 256 / 8; const int j2 = h2 ? i2 : i;
                const float4 a = ((const float4*)p.p)[2 * i], b = ((const float4*)p.p)[2 * i + 1], c2 = ((const float4*)p.p)[2 * j2], d2 = ((const float4*)p.p)[2 * j2 + 1];
                const float e[8] = {a.x, a.y, a.z, a.w, b.x, b.y, b.z, b.w}; ((u32x4*)pb)[i] = pack8(e);
                if (h2) { const float f[8] = {c2.x, c2.y, c2.z, c2.w, d2.x, d2.y, d2.z, d2.w}; ((u32x4*)pb)[i2] = pack8(f); } } }
        EpiSwiGLU E{(bf16_t*)(ws + OFF_B), ph == 13 ? (const float*)(ws + OFF_RS) + MT : nullptr}; run_gemm(lds, bA, W + (ph == 1 ? EW1GU : EW2GU), 5632, 1024, E, bid, G); } break;
    case 2: case 14: if PH_ON(2) { EpiResid E{ph == 2 ? p.x : p.out, p.out, bA, (float*)(ws + OFF_RS) + (ph == 2 ? 0 : 2 * MT), 0.5f, 0.f}; run_gemm(lds, (const bf16_t*)(ws + OFF_B), W + (ph == 2 ? EW1D : EW2D), 1024, 2816, E, bid, G); } break;
    case 3: if PH_ON(3) norm_rows(p.out, p.mix_norm, bA, gw, nw, lane); break;
    case 4: if PH_ON(4) { EpiWin E{ws, (const float*)(ws + OFF_RS)}; run_gemm(lds, bA, W + EWIN, 4864, 1024, E, bid, G); } break;
    case 5: if PH_ON(5) { lru_phase<false>(p, lds, bid, G); mid_rows(p, gw, nw, lane); } break;
    case 6: if PH_ON(6) lru_phase<true>(p, lds, bid, G); break;
    case 7: if PH_ON(7) { EpiGateMul E{bD, bD, (bf16_t*)(ws + OFF_B), 0}; run_gemm(lds, bA, W + EWLO, 1024, 1024, E, bid, G); } break;
    case 8: if PH_ON(8) { EpiQ Eq{bA, (bf16_t*)(ws + OFF_QR)}; run_gemm(lds, (const bf16_t*)(ws + OFF_CQN), W + EWUQ, 1536, 384, Eq, bid, G);
              EpiKV Ek{(bf16_t*)(ws + OFF_C), (bf16_t*)(ws + OFF_D)}; run_gemm(lds, (const bf16_t*)(ws + OFF_CKVN), W + EWUKV, 2048, 256, Ek, bid, G); } break;
    case 9: if PH_ON(9) attn_phase(p, (char*)smem, bid, G); break;
    case 10: if PH_ON(10) { EpiGateMul E{(const bf16_t*)(ws + OFF_E), (const bf16_t*)(ws + OFF_B), (bf16_t*)(ws + OFF_C), 1}; run_gemm(lds, bA, W + EWMO, 1024, 1024, E, bid, G); } break;
    case 11: if PH_ON(11) { EpiResid E{p.out, p.out, bA, (float*)(ws + OFF_RS) + MT, 1.0f, 0.f}; run_gemm(lds, (const bf16_t*)(ws + OFF_C), W + EWO, 1024, 1024, E, bid, G); } break;
    case 12: if PH_ON(12) norm_rows(p.out, p.ffn2_norm, bA, gw, nw, lane); break;
    case 15: if PH_ON(15) { norm_rows(p.out, p.ple_norm, bA, gw, nw, lane);
               bf16_t* pb = (bf16_t*)(ws + OFF_F);
               for (int i = gw * 64 + lane; i < MT * 256 / 8; i += nw * 64) { const float4 a = ((const float4*)p.p)[2 * i], b = ((const float4*)p.p)[2 * i + 1];
                   const float e[8] = {a.x, a.y, a.z, a.w, b.x, b.y, b.z, b.w}; ((u32x4*)pb)[i] = pack8(e); } } break;
    case 16: if PH_ON(16) { EpiF32Act<1> Eg{(float*)(ws + OFF_B), (const float*)(ws + OFF_RS) + 2 * MT}; run_gemm(lds, bA, W + EWPG, 1024, 1024, Eg, bid, G);
               EpiF32Act<0> Ep{(float*)(ws + OFF_D), nullptr}; run_gemm(lds, (const bf16_t*)(ws + OFF_F), W + EWPP, 1024, 256, Ep, bid, G); } break;
    case 17: if PH_ON(17) final_rows(p, gw, nw, lane); break;
    default: break;
    }
}

typedef const __attribute__((address_space(4))) Params* KP;
#if defined(__HIP_DEVICE_COMPILE__)
#define MK_PHASE(k) do { KP q = (KP)__builtin_amdgcn_kernarg_segment_ptr(); asm volatile("" : "+s"(q)); const Params lp = *q; run_phase(lp, (k), smem); } while (0)
#else
#define MK_PHASE(k) do { (void)smem; } while (0)
#endif
#if MK_ONE_LAUNCH
__device__ __forceinline__ void grid_bar(unsigned* ctr, unsigned target) {
    asm volatile("s_waitcnt vmcnt(0) lgkmcnt(0)" ::: "memory");
    __syncthreads();
    if (threadIdx.x == 0) {
        __builtin_amdgcn_fence(__ATOMIC_RELEASE, "agent");
        asm volatile("s_waitcnt vmcnt(0)" ::: "memory");
        __hip_atomic_fetch_add(ctr, 1u, __ATOMIC_RELAXED, __HIP_MEMORY_SCOPE_AGENT);
        while (__hip_atomic_load(ctr, __ATOMIC_RELAXED, __HIP_MEMORY_SCOPE_AGENT) < target) __builtin_amdgcn_s_sleep(2);
        __builtin_amdgcn_fence(__ATOMIC_ACQUIRE, "agent");
        asm volatile("s_waitcnt vmcnt(0)" ::: "memory");
    }
    __syncthreads();
}
__global__ void __launch_bounds__(512, 2) mk(Params p_unused) {
    extern __shared__ __attribute__((aligned(16))) unsigned char smem[];
    cg::grid_group grid = cg::this_grid();
    unsigned* ctr = nullptr; unsigned G = gridDim.x;
#if defined(__HIP_DEVICE_COMPILE__)
    { KP q = (KP)__builtin_amdgcn_kernarg_segment_ptr(); ctr = (unsigned*)(q->ws + OFF_BAR); }
#endif
    unsigned bt = 0;
#define GB(k) grid_bar(ctr, (bt += G))
    if (blockIdx.x == 0 && threadIdx.x == 0) __hip_atomic_store(ctr, 0u, __ATOMIC_RELAXED, __HIP_MEMORY_SCOPE_AGENT);
    MK_PHASE(0); grid.sync();
    MK_PHASE(1); GB(2); MK_PHASE(2); GB(3); MK_PHASE(4); GB(5); MK_PHASE(5); GB(6);
    MK_PHASE(6); GB(7); MK_PHASE(7); GB(8); MK_PHASE(8); GB(9); MK_PHASE(9); GB(10); MK_PHASE(10); GB(11); MK_PHASE(11); GB(12);
    MK_PHASE(13); GB(14); MK_PHASE(14); GB(15); MK_PHASE(16); GB(17); MK_PHASE(17);
#undef GB
}
#else
template <int PH> __global__ void __launch_bounds__(512, 2) mkp(Params p_unused) {
    extern __shared__ __attribute__((aligned(16))) unsigned char smem[];
    MK_PHASE(PH);
}
template <int PH> static void launch_phases(const Params& p, int grid, hipStream_t stream, bool setattr) {
    if constexpr (PH < NPHASE) {
        if (setattr) { if (hipFuncSetAttribute((const void*)mkp<PH>, hipFuncAttributeMaxDynamicSharedMemorySize, LDS_BYTES) != hipSuccess) fprintf(stderr, "kernel_launch: hipFuncSetAttribute failed (phase %d)\n", PH); }
        else {
#if defined(MK_DEBUG)
            if (PH == 9) hipLaunchKernelGGL(chk, dim3(1), dim3(64), 0, stream, p, 89);
            if (PH == 7) hipLaunchKernelGGL(chk, dim3(1), dim3(64), 0, stream, p, 70);
            if (PH == 10) hipLaunchKernelGGL(chk, dim3(1), dim3(64), 0, stream, p, 90);
            if (PH == 11) hipLaunchKernelGGL(chk, dim3(1), dim3(64), 0, stream, p, 91);
            if (PH == 14) hipLaunchKernelGGL(chk, dim3(1), dim3(64), 0, stream, p, 92);
            if (PH == 17) hipLaunchKernelGGL(chk, dim3(1), dim3(64), 0, stream, p, 93);
#endif
            hipLaunchKernelGGL(mkp<PH>, dim3(grid), dim3(512), LDS_BYTES, stream, p);
#if defined(MK_DEBUG)
            if (true) hipLaunchKernelGGL(chk, dim3(1), dim3(64), 0, stream, p, PH);
            if (PH == NPHASE - 1) hipLaunchKernelGGL(chk, dim3(1), dim3(64), 0, stream, p, MK_DEBUG);
#endif
        }
        launch_phases<PH + 1>(p, grid, stream, setattr);
    }
}
#endif

extern "C" void kernel_launch(void* const* d_in, const int* in_sizes, int n_in, void* d_out, int out_size, void* d_ws, size_t ws_size, hipStream_t stream) {
    static int grid = 0;
    if (grid == 0) {
        if (n_in != 32 || in_sizes[0] != MT * DM || out_size != MT * DM || ws_size < WS_NEED) {
            fprintf(stderr, "kernel_launch: unexpected shapes: n_in %d in0 %d out %d ws %zu (need %zu)\n", n_in, n_in > 0 ? in_sizes[0] : -1, out_size, ws_size, (size_t)WS_NEED); grid = -1; return; }
        int dev = 0, cus = 0, per_cu = 0;
        (void)hipGetDevice(&dev); (void)hipDeviceGetAttribute(&cus, hipDeviceAttributeMultiprocessorCount, dev);
#if MK_ONE_LAUNCH
        if (hipFuncSetAttribute((const void*)mk, hipFuncAttributeMaxDynamicSharedMemorySize, LDS_BYTES) != hipSuccess) { fprintf(stderr, "kernel_launch: hipFuncSetAttribute failed\n"); grid = -1; return; }
        if (hipOccupancyMaxActiveBlocksPerMultiprocessor(&per_cu, (const void*)mk, 512, LDS_BYTES) != hipSuccess || per_cu < 1) { fprintf(stderr, "kernel_launch: occupancy query gives %d\n", per_cu); per_cu = 1; }
#else
        { Params z{}; launch_phases<0>(z, 0, stream, true); }
#endif
        (void)hipGetLastError();
        grid = cus;
    }
    if (grid < 0) return;
    Params p{};
    p.x = (const float*)d_in[0]; p.p = (const float*)d_in[1]; p.pos = (const int*)d_in[2];
    p.ffn1_norm = (const float*)d_in[3]; p.ffn1_wg = (const float*)d_in[4]; p.ffn1_wu = (const float*)d_in[5]; p.ffn1_wd = (const float*)d_in[6];
    p.mix_norm = (const float*)d_in[7]; p.w_in = (const float*)d_in[8]; p.conv_w = (const float*)d_in[9]; p.conv_b = (const float*)d_in[10];
    p.lru_wr = (const float*)d_in[11]; p.lru_br = (const float*)d_in[12]; p.lru_wi = (const float*)d_in[13]; p.lru_bi = (const float*)d_in[14]; p.lru_lam = (const float*)d_in[15];
    p.w_lru_out = (const float*)d_in[16]; p.q_norm = (const float*)d_in[17]; p.w_uq = (const float*)d_in[18]; p.kv_norm = (const float*)d_in[19]; p.w_ukv = (const float*)d_in[20];
    p.w_mla_out = (const float*)d_in[21]; p.w_o = (const float*)d_in[22]; p.ffn2_norm = (const float*)d_in[23]; p.ffn2_wg = (const float*)d_in[24]; p.ffn2_wu = (const float*)d_in[25];
    p.ffn2_wd = (const float*)d_in[26]; p.ple_norm = (const float*)d_in[27]; p.ple_wg = (const float*)d_in[28]; p.ple_wp = (const float*)d_in[29]; p.ple_pn = (const float*)d_in[30];
    p.final_norm = (const float*)d_in[31];
    p.out = (float*)d_out; p.ws = (unsigned char*)d_ws;
    for (int i = 0; i < 32; ++i) p.inv_freq[i] = (float)pow(10000.0, -(double)(2 * i) / 64.0);
#if MK_ONE_LAUNCH
    void* args[] = {&p};
    hipError_t e = hipLaunchCooperativeKernel((const void*)mk, dim3(grid), dim3(512), args, LDS_BYTES, stream);
    if (e != hipSuccess) fprintf(stderr, "kernel_launch: cooperative launch failed: %s (grid %d)\n", hipGetErrorString(e), grid);
#else
    launch_phases<0>(p, grid, stream, false);
    hipError_t e = hipPeekAtLastError();
    if (e != hipSuccess) fprintf(stderr, "kernel_launch: launch failed: %s\n", hipGetErrorString(e));
#endif
}
```

```cpp
#include <hip/hip_runtime.h>
#include <hip/hip_cooperative_groups.h>
#include <cstdio>
#include <cmath>
namespace cg = cooperative_groups;
#ifndef MK_ONE_LAUNCH
#define MK_ONE_LAUNCH 1
#endif
namespace pg8 {
#define PG8_LAS __attribute__((address_space(3)))
typedef unsigned short bf16_t;
typedef short bf16x8 __attribute__((ext_vector_type(8)));
typedef float f32x4 __attribute__((ext_vector_type(4)));
typedef unsigned u32x4 __attribute__((ext_vector_type(4)));
constexpr int BM = 256, BK = 64, HALF = 128, HTB = HALF * BK * 2  , STAGE_BYTES = 8 * HTB, NXCD = 8, WGM = 8;

__host__ __device__ __forceinline__ int lds_byte(int r, int c) { const int st = (r >> 4) * 2 + (c >> 5), rr = r & 15, cc = c & 31, ob = rr * 64 + cc * 2; return st * 1024 + (ob ^ (((ob >> 9) & 1) << 5)); }
__host__ __device__ __forceinline__ void stage_rc(int b, int& R, int& C) { const int st = b / 1024, sb = b % 1024, swz = sb ^ (((sb >> 9) & 1) << 5); R = (st >> 1) * 16 + swz / 64; C = (st & 1) * 32 + (swz % 64) / 2; }
__host__ __device__ __forceinline__ int perm32(int rho) { const int n = rho >> 4, i = rho & 15; return 8 * (i >> 2) + 4 * n + (i & 3); }

struct Unit { int pm, pn; };
struct Gemm { const bf16_t* A; const bf16_t* Bt; int M, N, K; };

struct StaticOrder {
    int nM, nN, nwg, G, c;
    __host__ __device__ void init(int M, int N, int G_, int c_) { nM = M / BM; nN = N / BM; nwg = nM * nN; G = G_; c = c_; }
    __host__ __device__ bool next(int i, Unit& u) const {
        const long L = (long)i * G + c; if (L >= nwg) return false;
        int wgid = (int)L; { const int q = nwg / NXCD, r = nwg % NXCD, xcd = wgid % NXCD, off = wgid / NXCD; wgid = (xcd < r ? xcd * (q + 1) : r * (q + 1) + (xcd - r) * q) + off; }
        const int nig = WGM * nN, gid = wgid / nig, fm = gid * WGM, gsz = (nM - fm) < WGM ? (nM - fm) : WGM;
        u.pm = fm + ((wgid % nig) % gsz); u.pn = (wgid % nig) / gsz; return true;
    }
    __device__ __forceinline__ void a_ready(const Unit&) const {}
    __device__ __forceinline__ void done(const Unit&) const {}
};
typedef float cvt_f32x2 __attribute__((ext_vector_type(2)));
typedef __bf16 cvt_bf16x2 __attribute__((ext_vector_type(2)));
__device__ __forceinline__ unsigned cvt_pk_bf16(float lo, float hi) { const cvt_f32x2 v = {lo, hi}; const cvt_bf16x2 r = __builtin_convertvector(v, cvt_bf16x2); return __builtin_bit_cast(unsigned, r); }
typedef float f32x2 __attribute__((ext_vector_type(2)));
template <class Epi, class Sched, bool STAMP = false>
__device__ __forceinline__ void gemm_phase(PG8_LAS unsigned char* lds, const Gemm g, const Sched S, const Epi E, unsigned long long* stamps) {
    int tid_ = threadIdx.x; asm volatile("" : "+v"(tid_));
    const int tid = tid_, wid = __builtin_amdgcn_readfirstlane(tid >> 6), lane = tid & 63, wr = wid >> 2, wc = wid & 3, fr = lane & 15, fq = lane >> 4;
    const int K = g.K, nt = K / BK;
    int ts_lo = 0, ts_hi = 0, nts = 0; const unsigned long long rt_entry = STAMP ? (unsigned long long)wall_clock64() : 0ull;
#define PG8_STAMP() do { if (STAMP && wid == 0 && nts < 64) { const unsigned long long _c = (unsigned long long)clock64(); \
        ts_lo = (lane == nts) ? (int)(unsigned)_c : ts_lo; ts_hi = (lane == nts) ? (int)(unsigned)(_c >> 32) : ts_hi; ++nts; } } while (0)
    PG8_STAMP();
    unsigned voffA[2], voffB[2];
#pragma unroll
    for (int i = 0; i < 2; ++i) { int R, C; stage_rc(tid * 16 + i * 8192, R, C); const int Rb = Epi::PERM ? ((R & ~31) + perm32(R & 31)) : R;
        voffA[i] = (unsigned)(R * K + C) * 2u; voffB[i] = (unsigned)(Rb * K + C) * 2u; }
    const size_t kstep = (size_t)(BK * 2);
    const size_t hstep = (size_t)HALF * K * 2;
    const size_t tstep = 2 * hstep;
    const unsigned ldsw = (unsigned)wid * 1024u;
    const int aoff = lds_byte(wr * 64 + fr, fq * 8), boff = lds_byte(wc * 32 + fr, fq * 8);
#define PG8_SA(b, h) (((b) * 2 + (h)) * HTB)
#define PG8_SB(b, h) ((4 + (b) * 2 + (h)) * HTB)
#define PG8_STAGE(bufoff, gbase, voff) do { _Pragma("unroll") for (int _i = 0; _i < 2; ++_i) \
        __builtin_amdgcn_global_load_lds((const unsigned*)((const char*)(gbase) + (voff)[_i]), (PG8_LAS unsigned*)(lds + (bufoff) + ldsw + _i * 8192), 16, 0, 0); } while (0)
#define PG8_LDA(dst, b, h) do { _Pragma("unroll") for (int m = 0; m < 4; ++m) _Pragma("unroll") for (int k = 0; k < 2; ++k) dst[m][k] = *(const PG8_LAS bf16x8*)(lds + PG8_SA(b, h) + aoff + m * 2048 + k * 1024); } while (0)
#define PG8_LDB(dst, b, h) do { _Pragma("unroll") for (int n = 0; n < 2; ++n) _Pragma("unroll") for (int k = 0; k < 2; ++k) dst[n][k] = *(const PG8_LAS bf16x8*)(lds + PG8_SB(b, h) + boff + n * 2048 + k * 1024); } while (0)
#define PG8_MMA(ai, bj, At, Bt) do { __builtin_amdgcn_s_setprio(1); _Pragma("unroll") for (int m = 0; m < 4; ++m) _Pragma("unroll") for (int n = 0; n < 2; ++n) _Pragma("unroll") for (int k = 0; k < 2; ++k) \
        acc[ai][bj][m][n] = __builtin_amdgcn_mfma_f32_16x16x32_bf16(Bt[n][k], At[m][k], acc[ai][bj][m][n], 0, 0, 0); __builtin_amdgcn_s_setprio(0); } while (0)
#define PG8_WAIT_V(n) asm volatile("s_waitcnt vmcnt(" #n ")" ::: "memory")
#define PG8_WAIT_L(n) asm volatile("s_waitcnt lgkmcnt(" #n ")" ::: "memory")
#define PG8_BAR __builtin_amdgcn_s_barrier()
#define PG8_SCHED __builtin_amdgcn_sched_barrier(0)
    Unit cur, nxt; int ui = 0;
    if (!S.next(0, cur)) return;
    f32x4 acc[2][2][4][2];
#pragma unroll
    for (int a = 0; a < 2; ++a)
#pragma unroll
        for (int b = 0; b < 2; ++b)
#pragma unroll
            for (int m = 0; m < 4; ++m)
#pragma unroll
                for (int n = 0; n < 2; ++n) acc[a][b][m][n] = (f32x4){0.f, 0.f, 0.f, 0.f};
    bf16x8 At[4][2], B0[2][2], B1[2][2];
    const char* cA = (const char*)g.A + (size_t)cur.pm * tstep; const char* cB = (const char*)g.Bt + (size_t)cur.pn * tstep;
    S.a_ready(cur);
    PG8_STAGE(PG8_SB(0, 0), cB, voffB); PG8_STAGE(PG8_SA(0, 0), cA, voffA); PG8_STAGE(PG8_SB(0, 1), cB + hstep, voffB); PG8_STAGE(PG8_SA(0, 1), cA + hstep, voffA);
    if (wr == 1) PG8_BAR;
    PG8_WAIT_V(4); PG8_BAR;
    PG8_STAGE(PG8_SB(1, 0), cB + kstep, voffB); PG8_STAGE(PG8_SA(1, 0), cA + kstep, voffA); PG8_STAGE(PG8_SB(1, 1), cB + hstep + kstep, voffB);
    PG8_WAIT_V(6); PG8_BAR;
    PG8_STAMP();
    for (;;) {
        const bool has_next = S.next(ui + 1, nxt);
        const char* nA = has_next ? (const char*)g.A + (size_t)nxt.pm * tstep : cA; const char* nB = has_next ? (const char*)g.Bt + (size_t)nxt.pn * tstep : cB;
        for (int t = 0; t < nt; t += 2) {
            const bool last = (t == nt - 2);
            const char* a1 = cA + (size_t)(t + 1) * kstep;
            const char* a2 = last ? nA : cA + (size_t)(t + 2) * kstep; const char* b2 = last ? nB : cB + (size_t)(t + 2) * kstep;
            const char* a3 = a2 + kstep; const char* b3 = b2 + kstep;
            if (last && has_next) S.a_ready(nxt);
            PG8_LDB(B0, 0, 0); PG8_SCHED; PG8_LDA(At, 0, 0); PG8_STAGE(PG8_SA(1, 1), a1 + hstep, voffA);
            PG8_WAIT_L(8); PG8_BAR; PG8_WAIT_L(0); PG8_MMA(0, 0, At, B0); PG8_BAR; PG8_SCHED;
            PG8_LDB(B1, 0, 1); PG8_STAGE(PG8_SB(0, 0), b2, voffB);
            PG8_BAR; PG8_WAIT_L(0); PG8_MMA(0, 1, At, B1); PG8_BAR;
            PG8_LDA(At, 0, 1); PG8_STAGE(PG8_SA(0, 0), a2, voffA);
            PG8_BAR; PG8_WAIT_L(0); PG8_MMA(1, 0, At, B0); PG8_BAR; PG8_SCHED;
            PG8_STAGE(PG8_SB(0, 1), b2 + hstep, voffB);
            PG8_WAIT_V(6); PG8_BAR; PG8_MMA(1, 1, At, B1); PG8_BAR;
            PG8_LDB(B0, 1, 0); PG8_SCHED; PG8_LDA(At, 1, 0); PG8_STAGE(PG8_SA(0, 1), a2 + hstep, voffA);
            PG8_WAIT_L(8); PG8_BAR; PG8_WAIT_L(0); PG8_MMA(0, 0, At, B0); PG8_BAR; PG8_SCHED;
            PG8_LDB(B1, 1, 1); PG8_STAGE(PG8_SB(1, 0), b3, voffB);
            PG8_BAR; PG8_WAIT_L(0); PG8_MMA(0, 1, At, B1); PG8_BAR;
            PG8_LDA(At, 1, 1); PG8_STAGE(PG8_SA(1, 0), a3, voffA);
            PG8_BAR; PG8_WAIT_L(0); PG8_MMA(1, 0, At, B0); PG8_BAR; PG8_SCHED;
            PG8_STAGE(PG8_SB(1, 1), b3 + hstep, voffB);
            PG8_WAIT_V(6); PG8_BAR; PG8_MMA(1, 1, At, B1); PG8_BAR;
        }
        PG8_STAMP();
        if constexpr (!Epi::AFTER_DRAIN) { E(acc, cur, wr, wc, fr, fq); S.done(cur); }
        PG8_STAMP();
        if (!has_next) break;
#pragma unroll
        for (int a = 0; a < 2; ++a)
#pragma unroll
            for (int b = 0; b < 2; ++b)
#pragma unroll
                for (int m = 0; m < 4; ++m)
#pragma unroll
                    for (int n = 0; n < 2; ++n) acc[a][b][m][n] = (f32x4){0.f, 0.f, 0.f, 0.f};
        cur = nxt; cA = nA; cB = nB; ++ui;
    }
    PG8_WAIT_V(0);
    if (wr == 0) PG8_BAR;
    PG8_BAR;
    if constexpr (Epi::AFTER_DRAIN) { E.fused(acc, cur, wr, wc, fr, fq, lds, wid, lane); S.done(cur); }
    PG8_STAMP();
    if (STAMP && wid == 0) { stamps[lane] = lane < nts ? (((unsigned long long)(unsigned)ts_hi << 32) | (unsigned)ts_lo) : 0ull;
        if (lane == 62) stamps[62] = rt_entry; if (lane == 63) stamps[63] = (unsigned long long)wall_clock64(); }
#undef PG8_STAMP
#undef PG8_SA
#undef PG8_SB
#undef PG8_STAGE
#undef PG8_LDA
#undef PG8_LDB
#undef PG8_MMA
#undef PG8_WAIT_V
#undef PG8_WAIT_L
#undef PG8_BAR
#undef PG8_SCHED
}
}

#define LAS __attribute__((address_space(3)))
typedef unsigned short bf16_t;
typedef short bf16x8 __attribute__((ext_vector_type(8)));
typedef short s16x4 __attribute__((ext_vector_type(4)));
typedef float f32x4 __attribute__((ext_vector_type(4)));
typedef float f32x16 __attribute__((ext_vector_type(16)));
typedef unsigned u32x4 __attribute__((ext_vector_type(4)));
typedef unsigned u32x2 __attribute__((ext_vector_type(2)));
using pg8::cvt_pk_bf16;

constexpr int MT = 32768, SEQ = 4096, DM = 1024, DFF = 2816;
constexpr float EPS = 1e-6f;
constexpr size_t UU = 67108864ull;
constexpr size_t EW1GU = 0, EW1D = 5767168, EWIN = 8650752, EWG = 13631488, EWUQ = 14155776, EWUKV = 14745600, EWLO = 15269888,
                 EWMO = 16318464, EWO = 17367040, EW2GU = 18415616, EW2D = 24182784, EWPG = 27066368, EWPP = 28114944;
constexpr size_t OFF_INVF = 55ull << 20;
constexpr size_t OFF_RS = (55ull << 20) + (600ull << 10);
constexpr size_t OFF_BAR = (55ull << 20) + (512ull << 10);
constexpr size_t OFF_CARP = 56ull << 20, OFF_CARH = 60ull << 20;
constexpr size_t OFF_A = UU, OFF_B = 2 * UU, OFF_C = 3 * UU, OFF_D = 4 * UU, OFF_E = 5 * UU, OFF_F = 6 * UU, OFF_G = 6 * UU + UU / 2, OFF_H = 6 * UU + 3 * UU / 4;
constexpr size_t OFF_CQN = OFF_H, OFF_CKVN = OFF_CQN + 3 * UU / 8, OFF_KPE = OFF_CKVN + UU / 4, OFF_QR = OFF_KPE + UU / 16;
constexpr size_t WS_NEED = 8 * UU;
static_assert(OFF_QR + UU / 2 <= WS_NEED, "workspace map");
constexpr int LDS_BYTES = 152576;
constexpr int NPHASE = 18;

struct Params {
    const float *x, *p; const int* pos;
    const float *ffn1_norm, *ffn1_wg, *ffn1_wu, *ffn1_wd, *mix_norm, *w_in, *conv_w, *conv_b, *lru_wr, *lru_br, *lru_wi, *lru_bi, *lru_lam, *w_lru_out,
        *q_norm, *w_uq, *kv_norm, *w_ukv, *w_mla_out, *w_o, *ffn2_norm, *ffn2_wg, *ffn2_wu, *ffn2_wd, *ple_norm, *ple_wg, *ple_wp, *ple_pn, *final_norm;
    float* out; unsigned char* ws;
    float inv_freq[32];
};

__device__ __forceinline__ float bflo(unsigned w) { return __uint_as_float(w << 16); }
__device__ __forceinline__ float bfhi(unsigned w) { return __uint_as_float(w & 0xffff0000u); }
__device__ __forceinline__ float bf2f(bf16_t b) { return __uint_as_float(((unsigned)b) << 16); }
__device__ __forceinline__ bf16_t f2bf(float f) { return (bf16_t)(cvt_pk_bf16(f, f) & 0xffffu); }
__device__ __forceinline__ float fsigmoid(float x) { return __builtin_amdgcn_rcpf(1.0f + __expf(-x)); }
__device__ __forceinline__ float fsilu(float x) { return x * fsigmoid(x); }
__device__ __forceinline__ float fgelu_tanh(float x) { return x * fsigmoid(1.5957691216057308f * (x + 0.044715f * x * x * x)); }
__device__ __forceinline__ float wave_sum(float v, int lane) {
#pragma unroll
    for (int o = 32; o >= 1; o >>= 1) v += __uint_as_float((unsigned)__builtin_amdgcn_ds_bpermute((lane ^ o) << 2, (int)__float_as_uint(v)));
    return v;
}
__device__ __forceinline__ void rope_cs(float ang, float& c, float& s) {
    const float k = rintf(ang * 0.15915494309189535f);
    float r = fmaf(-k, 6.28318548202514648f, ang); r = fmaf(-k, -1.74845553e-07f, r);
    const float rev = r * 0.15915494309189535f;
    s = __builtin_amdgcn_sinf(rev); c = __builtin_amdgcn_cosf(rev);
}
__device__ __forceinline__ u32x4 pack8(const float (&e)[8]) { u32x4 w; w.x = cvt_pk_bf16(e[0], e[1]); w.y = cvt_pk_bf16(e[2], e[3]); w.z = cvt_pk_bf16(e[4], e[5]); w.w = cvt_pk_bf16(e[6], e[7]); return w; }
__device__ __forceinline__ void unpack8(u32x4 w, float (&e)[8]) { e[0] = bflo(w.x); e[1] = bfhi(w.x); e[2] = bflo(w.y); e[3] = bfhi(w.y); e[4] = bflo(w.z); e[5] = bfhi(w.z); e[6] = bflo(w.w); e[7] = bfhi(w.w); }

struct WtCtx { LAS float* tile; int gw, nw, lane, base; };
__device__ __forceinline__ void wt_job(WtCtx& c, const float* __restrict__ src, int K, int ldn, int n0, int ncols, bf16_t* __restrict__ dst, int ldd, int drow0, int grp, int gstride, const float* __restrict__ kscale = nullptr) {
    const int tk = K >> 6, tn = ncols >> 5, nt = tk * tn;
    int t = c.gw - c.base; if (t < 0) t += c.nw;
    const int rr = c.lane >> 3, c4 = (c.lane & 7) << 2, ks = c.lane & 7, nn = c.lane >> 3;
    for (; t < nt; t += c.nw) {
        const int nti = t % tn, kti = t / tn, k0 = kti << 6, j0 = nti << 5;
        float4 v[8];
#pragma unroll
        for (int i = 0; i < 8; ++i) v[i] = *(const float4*)(src + (size_t)(k0 + rr + 8 * i) * ldn + n0 + j0 + c4);
#pragma unroll
        for (int i = 0; i < 8; ++i) { LAS float* q = c.tile + (rr + 8 * i) * 33 + c4; q[0] = v[i].x; q[1] = v[i].y; q[2] = v[i].z; q[3] = v[i].w; }
        asm volatile("s_waitcnt lgkmcnt(0)" ::: "memory");
#pragma unroll
        for (int ps = 0; ps < 4; ++ps) {
            const int n = ps * 8 + nn;
            float e[8];
#pragma unroll
            for (int i = 0; i < 8; ++i) e[i] = c.tile[(ks * 8 + i) * 33 + n];
            if (kscale) {
#pragma unroll
                for (int i = 0; i < 8; ++i) e[i] *= kscale[k0 + ks * 8 + i]; }
            const int j = j0 + n, drow = drow0 + (j / grp) * gstride + (j % grp);
            *(u32x4*)(dst + (size_t)drow * ldd + k0 + ks * 8) = pack8(e);
        }
        asm volatile("s_waitcnt lgkmcnt(0)" ::: "memory");
    }
    c.base = (c.base + nt) % c.nw;
}

__device__ __forceinline__ void norm_rows(const float* in, const float* __restrict__ g, bf16_t* __restrict__ out, int gw, int nw, int lane) {
    float4 gv[4];
#pragma unroll
    for (int i = 0; i < 4; ++i) gv[i] = ((const float4*)g)[lane + 64 * i];
    for (int row = gw; row < MT; row += 2 * nw) {
        const int row2 = row + nw; const bool has2 = row2 < MT;
        const float4* p = (const float4*)(in + (size_t)row * DM); const float4* p2 = (const float4*)(in + (size_t)(has2 ? row2 : row) * DM);
        float4 v[4], w2[4];
#pragma unroll
        for (int i = 0; i < 4; ++i) { v[i] = p[lane + 64 * i]; w2[i] = p2[lane + 64 * i]; }
        float ss = 0.f, s2 = 0.f;
#pragma unroll
        for (int i = 0; i < 4; ++i) { ss += v[i].x * v[i].x + v[i].y * v[i].y + v[i].z * v[i].z + v[i].w * v[i].w; s2 += w2[i].x * w2[i].x + w2[i].y * w2[i].y + w2[i].z * w2[i].z + w2[i].w * w2[i].w; }
        ss = wave_sum(ss, lane); s2 = wave_sum(s2, lane);
        const float rs = rsqrtf(ss * (1.0f / 1024.0f) + EPS), rs2 = rsqrtf(s2 * (1.0f / 1024.0f) + EPS);
#pragma unroll
        for (int i = 0; i < 4; ++i) {
            u32x2 w; w.x = cvt_pk_bf16(v[i].x * rs * gv[i].x, v[i].y * rs * gv[i].y); w.y = cvt_pk_bf16(v[i].z * rs * gv[i].z, v[i].w * rs * gv[i].w);
            *(u32x2*)(out + (size_t)row * DM + 4 * (lane + 64 * i)) = w;
            if (has2) { u32x2 y; y.x = cvt_pk_bf16(w2[i].x * rs2 * gv[i].x, w2[i].y * rs2 * gv[i].y); y.y = cvt_pk_bf16(w2[i].z * rs2 * gv[i].z, w2[i].w * rs2 * gv[i].w);
                *(u32x2*)(out + (size_t)row2 * DM + 4 * (lane + 64 * i)) = y; }
        }
    }
}

__device__ __forceinline__ void mid_rows(const Params& p, int gw, int nw, int lane) {
    const bf16_t* cqkr = (const bf16_t*)(p.ws + OFF_F); const bf16_t* ckv = (const bf16_t*)(p.ws + OFF_G);
    bf16_t* cqn = (bf16_t*)(p.ws + OFF_CQN); bf16_t* ckvn = (bf16_t*)(p.ws + OFF_CKVN); bf16_t* kpe = (bf16_t*)(p.ws + OFF_KPE);
    const float* invf = (const float*)(p.ws + OFF_INVF);
    float2 gq[3], gk[2];
#pragma unroll
    for (int i = 0; i < 3; ++i) gq[i] = ((const float2*)p.q_norm)[lane + 64 * i];
#pragma unroll
    for (int i = 0; i < 2; ++i) gk[i] = ((const float2*)p.kv_norm)[lane + 64 * i];
    const float fi = invf[lane & 31];
    for (int row = gw; row < MT; row += nw) {
        const unsigned* q32 = (const unsigned*)(cqkr + (size_t)row * 512);
        const unsigned* k32 = (const unsigned*)(ckv + (size_t)row * 256);
        unsigned a[3], b[2];
#pragma unroll
        for (int i = 0; i < 3; ++i) a[i] = q32[lane + 64 * i];
#pragma unroll
        for (int i = 0; i < 2; ++i) b[i] = k32[lane + 64 * i];
        const float x1 = bf2f(cqkr[(size_t)row * 512 + 384 + (lane & 31)]), x2 = bf2f(cqkr[(size_t)row * 512 + 416 + (lane & 31)]);
        const float posf = (float)p.pos[row];
        float sq = 0.f, sk = 0.f;
#pragma unroll
        for (int i = 0; i < 3; ++i) { const float lo = bflo(a[i]), hi = bfhi(a[i]); sq += lo * lo + hi * hi; }
#pragma unroll
        for (int i = 0; i < 2; ++i) { const float lo = bflo(b[i]), hi = bfhi(b[i]); sk += lo * lo + hi * hi; }
        sq = wave_sum(sq, lane); sk = wave_sum(sk, lane);
        const float rq = rsqrtf(sq * (1.0f / 384.0f) + EPS), rk = rsqrtf(sk * (1.0f / 256.0f) + EPS);
        unsigned* oq = (unsigned*)(cqn + (size_t)row * 384); unsigned* ok = (unsigned*)(ckvn + (size_t)row * 256);
#pragma unroll
        for (int i = 0; i < 3; ++i) oq[lane + 64 * i] = cvt_pk_bf16(bflo(a[i]) * rq * gq[i].x, bfhi(a[i]) * rq * gq[i].y);
#pragma unroll
        for (int i = 0; i < 2; ++i) ok[lane + 64 * i] = cvt_pk_bf16(bflo(b[i]) * rk * gk[i].x, bfhi(b[i]) * rk * gk[i].y);
        float cs, sn; rope_cs(posf * fi, cs, sn);
        if (lane < 32) { kpe[(size_t)row * 64 + lane] = f2bf(x1 * cs - x2 * sn); kpe[(size_t)row * 64 + 32 + lane] = f2bf(x2 * cs + x1 * sn); }
    }
}

__device__ __forceinline__ void final_row_one(const Params& p, const float* gate, const float* pp, int row, int lane, const float4 (&g1)[4], const float4 (&g2)[4], const float4 (&h0)[4], const float4 (&g)[4], const float4 (&q)[4]) {
    float4 h[4];
    float s1 = 0.f;
#pragma unroll
    for (int i = 0; i < 4; ++i) { h[i] = h0[i]; s1 += q[i].x * q[i].x + q[i].y * q[i].y + q[i].z * q[i].z + q[i].w * q[i].w; }
    s1 = wave_sum(s1, lane);
    const float r1 = rsqrtf(s1 * (1.0f / 1024.0f) + EPS);
    float s2 = 0.f;
#pragma unroll
    for (int i = 0; i < 4; ++i) {
        h[i].x += g[i].x * (q[i].x * r1 * g1[i].x); h[i].y += g[i].y * (q[i].y * r1 * g1[i].y); h[i].z += g[i].z * (q[i].z * r1 * g1[i].z); h[i].w += g[i].w * (q[i].w * r1 * g1[i].w);
        s2 += h[i].x * h[i].x + h[i].y * h[i].y + h[i].z * h[i].z + h[i].w * h[i].w;
    }
    s2 = wave_sum(s2, lane);
    const float r2 = rsqrtf(s2 * (1.0f / 1024.0f) + EPS);
    float4* ph = (float4*)(p.out + (size_t)row * DM);
#pragma unroll
    for (int i = 0; i < 4; ++i) { float4 o; o.x = h[i].x * r2 * g2[i].x; o.y = h[i].y * r2 * g2[i].y; o.z = h[i].z * r2 * g2[i].z; o.w = h[i].w * r2 * g2[i].w; ph[lane + 64 * i] = o; }
}
__device__ __forceinline__ void final_rows(const Params& p, int gw, int nw, int lane) {
    const float* gate = (const float*)(p.ws + OFF_B); const float* pp = (const float*)(p.ws + OFF_D);
    float4 g1[4], g2[4];
#pragma unroll
    for (int i = 0; i < 4; ++i) { g1[i] = ((const float4*)p.ple_pn)[lane + 64 * i]; g2[i] = ((const float4*)p.final_norm)[lane + 64 * i]; }
    for (int row = gw; row < MT; row += 2 * nw) {
        const int row2 = row + nw; const bool has2 = row2 < MT; const int rb = has2 ? row2 : row;
        float4 ha[4], ga[4], qa[4], hb[4], gb[4], qb[4];
#pragma unroll
        for (int i = 0; i < 4; ++i) {
            ha[i] = ((const float4*)(p.out + (size_t)row * DM))[lane + 64 * i]; ga[i] = ((const float4*)(gate + (size_t)row * DM))[lane + 64 * i]; qa[i] = ((const float4*)(pp + (size_t)row * DM))[lane + 64 * i];
            hb[i] = ((const float4*)(p.out + (size_t)rb * DM))[lane + 64 * i]; gb[i] = ((const float4*)(gate + (size_t)rb * DM))[lane + 64 * i]; qb[i] = ((const float4*)(pp + (size_t)rb * DM))[lane + 64 * i];
        }
        final_row_one(p, gate, pp, row, lane, g1, g2, ha, ga, qa);
        if (has2) final_row_one(p, gate, pp, row2, lane, g1, g2, hb, gb, qb);
    }
}

template <int ACT> __device__ __forceinline__ void store_bf16_tile(const f32x4 (&acc)[2][2][4][2], bf16_t* O, int ld, int row0, int col0, const float* rs = nullptr) {
#pragma unroll
    for (int ai = 0; ai < 2; ++ai)
#pragma unroll
        for (int m = 0; m < 4; ++m) {
            bf16_t* rowp = O + (size_t)(row0 + ai * 128 + m * 16) * ld + col0;
            const float sc = rs ? rsqrtf(rs[row0 + ai * 128 + m * 16] * (1.0f / 1024.0f) + EPS) : 1.0f;
#pragma unroll
            for (int bj = 0; bj < 2; ++bj) {
                float e[8];
#pragma unroll
                for (int j = 0; j < 4; ++j) { e[j] = acc[ai][bj][m][0][j] * sc; e[4 + j] = acc[ai][bj][m][1][j] * sc; }
                if (ACT == 1) {
#pragma unroll
                    for (int j = 0; j < 8; ++j) e[j] = fgelu_tanh(e[j]);
                }
                if (ACT == 2) {
#pragma unroll
                    for (int j = 0; j < 8; ++j) e[j] = fsigmoid(e[j]);
                }
                *(u32x4*)(rowp + bj * 128) = pack8(e);
            }
        }
}
struct EpiSwiGLU {
    static constexpr bool PERM = true, AFTER_DRAIN = false; bf16_t* O; const float* rs;
    __device__ __forceinline__ void operator()(const f32x4 (&acc)[2][2][4][2], const pg8::Unit& u, int wr, int wc, int fr, int fq) const {
        const int row0 = u.pm * 256 + wr * 64 + fr, col0 = u.pn * 128 + wc * 32 + 8 * fq;
#pragma unroll
        for (int ai = 0; ai < 2; ++ai)
#pragma unroll
            for (int m = 0; m < 4; ++m) {
                const float sc = rs ? rsqrtf(rs[row0 + ai * 128 + m * 16] * (1.0f / 1024.0f) + EPS) : 1.0f;
                float e[8];
#pragma unroll
                for (int j = 0; j < 4; ++j) { e[j] = fsilu(acc[ai][0][m][0][j] * sc) * (acc[ai][1][m][0][j] * sc); e[4 + j] = fsilu(acc[ai][0][m][1][j] * sc) * (acc[ai][1][m][1][j] * sc); }
                *(u32x4*)(O + (size_t)(row0 + ai * 128 + m * 16) * DFF + col0) = pack8(e);
            }
    }
};
struct EpiResid {
    static constexpr bool PERM = false, AFTER_DRAIN = false; const float* base; float* out; bf16_t* hb; float* rs; float alpha; float pad_;
    __device__ __forceinline__ void operator()(const f32x4 (&acc)[2][2][4][2], const pg8::Unit& u, int wr, int wc, int fr, int fq) const {
        const int row0 = u.pm * 256 + wr * 64 + fr, col0 = u.pn * 256 + wc * 32 + 4 * fq;
#pragma unroll
        for (int ai = 0; ai < 2; ++ai)
#pragma unroll
            for (int m = 0; m < 4; ++m) {
                const size_t off = (size_t)(row0 + ai * 128 + m * 16) * DM + col0;
                float ssq = 0.f;
#pragma unroll
                for (int bj = 0; bj < 2; ++bj)
#pragma unroll
                    for (int n = 0; n < 2; ++n) { const f32x4 b = *(const f32x4*)(base + off + bj * 128 + n * 16); const f32x4 h = b + alpha * acc[ai][bj][m][n]; *(f32x4*)(out + off + bj * 128 + n * 16) = h;
                        if (hb) { u32x2 w; w.x = cvt_pk_bf16(h[0], h[1]); w.y = cvt_pk_bf16(h[2], h[3]); *(u32x2*)(hb + off + bj * 128 + n * 16) = w; ssq += h[0] * h[0] + h[1] * h[1] + h[2] * h[2] + h[3] * h[3]; } }
                if (hb) { ssq += __shfl_xor(ssq, 16); ssq += __shfl_xor(ssq, 32); if (fq == 0) (void)__hip_atomic_fetch_add(rs + row0 + ai * 128 + m * 16, ssq, __ATOMIC_RELAXED, __HIP_MEMORY_SCOPE_AGENT); }
            }
    }
};
template <int ACT> struct EpiF32Act {
    static constexpr bool PERM = false, AFTER_DRAIN = false; float* out; const float* rs;
    __device__ __forceinline__ void operator()(const f32x4 (&acc)[2][2][4][2], const pg8::Unit& u, int wr, int wc, int fr, int fq) const {
        const int row0 = u.pm * 256 + wr * 64 + fr, col0 = u.pn * 256 + wc * 32 + 4 * fq;
#pragma unroll
        for (int ai = 0; ai < 2; ++ai)
#pragma unroll
            for (int m = 0; m < 4; ++m) {
                const size_t off = (size_t)(row0 + ai * 128 + m * 16) * DM + col0;
                const float sc = rs ? rsqrtf(rs[row0 + ai * 128 + m * 16] * (1.0f / 1024.0f) + EPS) : 1.0f;
#pragma unroll
                for (int bj = 0; bj < 2; ++bj)
#pragma unroll
                    for (int n = 0; n < 2; ++n) { f32x4 v = acc[ai][bj][m][n] * sc;
                        if (ACT == 1) { v[0] = fsigmoid(v[0]); v[1] = fsigmoid(v[1]); v[2] = fsigmoid(v[2]); v[3] = fsigmoid(v[3]); }
                        *(f32x4*)(out + off + bj * 128 + n * 16) = v; }
            }
    }
};
struct EpiWin {
    static constexpr bool PERM = true, AFTER_DRAIN = false; unsigned char* ws; const float* rs;
    __device__ __forceinline__ void operator()(const f32x4 (&acc)[2][2][4][2], const pg8::Unit& u, int wr, int wc, int fr, int fq) const {
        const int pn = u.pn, row0 = u.pm * 256 + wr * 64 + fr, cw = wc * 32 + 8 * fq;
        if (pn < 4) store_bf16_tile<0>(acc, (bf16_t*)(ws + OFF_B), 1024, row0, 256 * pn + cw, rs);
        else if (pn < 8) store_bf16_tile<1>(acc, (bf16_t*)(ws + OFF_C), 1024, row0, 256 * (pn - 4) + cw, rs);
        else if (pn < 11) { bf16_t* O = (bf16_t*)(ws + (pn == 8 ? OFF_G : OFF_F)); const int ld = pn == 8 ? 256 : 512, c0 = pn == 8 ? 0 : 256 * (pn - 9); store_bf16_tile<0>(acc, O, ld, row0, c0 + cw, rs); }
        else { bf16_t* O = (bf16_t*)(ws + (pn < 15 ? OFF_D : OFF_E)); const int c0 = 256 * (pn < 15 ? pn - 11 : pn - 15); store_bf16_tile<2>(acc, O, 1024, row0, c0 + cw, rs); }
    }
};
struct EpiGateMul {
    static constexpr bool PERM = true, AFTER_DRAIN = false; const bf16_t* G; const bf16_t* T; bf16_t* O; int add;
    __device__ __forceinline__ void operator()(const f32x4 (&acc)[2][2][4][2], const pg8::Unit& u, int wr, int wc, int fr, int fq) const {
        const int row0 = u.pm * 256 + wr * 64 + fr, col0 = u.pn * 256 + wc * 32 + 8 * fq;
#pragma unroll
        for (int ai = 0; ai < 2; ++ai)
#pragma unroll
            for (int m = 0; m < 4; ++m) {
                const size_t off = (size_t)(row0 + ai * 128 + m * 16) * DM + col0;
#pragma unroll
                for (int bj = 0; bj < 2; ++bj) {
                    float g[8], e[8]; unpack8(*(const u32x4*)(G + off + bj * 128), g);
#pragma unroll
                    for (int j = 0; j < 4; ++j) { e[j] = g[j] * acc[ai][bj][m][0][j]; e[4 + j] = g[4 + j] * acc[ai][bj][m][1][j]; }
                    if (add) { float t[8]; unpack8(*(const u32x4*)(T + off + bj * 128), t);
#pragma unroll
                        for (int j = 0; j < 8; ++j) e[j] += t[j]; }
                    *(u32x4*)(O + off + bj * 128) = pack8(e);
                }
            }
    }
};
struct EpiQ {
    static constexpr bool PERM = true, AFTER_DRAIN = false; bf16_t* Qn; bf16_t* Qr;
    __device__ __forceinline__ void operator()(const f32x4 (&acc)[2][2][4][2], const pg8::Unit& u, int wr, int wc, int fr, int fq) const {
        const int row0 = u.pm * 256 + wr * 64 + fr;
        if (u.pn < 4) { store_bf16_tile<0>(acc, Qn, 1024, row0, 256 * u.pn + wc * 32 + 8 * fq); return; }
        const int head = 4 * (u.pn - 4) + wc;
#pragma unroll
        for (int ai = 0; ai < 2; ++ai)
#pragma unroll
            for (int m = 0; m < 4; ++m) {
                bf16_t* dst = Qr + (size_t)(row0 + ai * 128 + m * 16) * 512 + 64 * head + 8 * fq;
                float e[8];
#pragma unroll
                for (int j = 0; j < 4; ++j) { e[j] = acc[ai][0][m][0][j]; e[4 + j] = acc[ai][0][m][1][j]; }
                *(u32x4*)dst = pack8(e);
#pragma unroll
                for (int j = 0; j < 4; ++j) { e[j] = acc[ai][1][m][0][j]; e[4 + j] = acc[ai][1][m][1][j]; }
                *(u32x4*)(dst + 32) = pack8(e);
            }
    }
};
struct EpiKV {
    static constexpr bool PERM = true, AFTER_DRAIN = false; bf16_t* Kn; bf16_t* V;
    __device__ __forceinline__ void operator()(const f32x4 (&acc)[2][2][4][2], const pg8::Unit& u, int wr, int wc, int fr, int fq) const {
        const int row0 = u.pm * 256 + wr * 64 + fr, col0 = u.pn * 128 + wc * 32 + 8 * fq;
#pragma unroll
        for (int ai = 0; ai < 2; ++ai)
#pragma unroll
            for (int m = 0; m < 4; ++m) {
                const size_t off = (size_t)(row0 + ai * 128 + m * 16) * DM + col0;
                float e[8];
#pragma unroll
                for (int j = 0; j < 4; ++j) { e[j] = acc[ai][0][m][0][j]; e[4 + j] = acc[ai][0][m][1][j]; }
                *(u32x4*)(Kn + off) = pack8(e);
#pragma unroll
                for (int j = 0; j < 4; ++j) { e[j] = acc[ai][1][m][0][j]; e[4 + j] = acc[ai][1][m][1][j]; }
                *(u32x4*)(V + off) = pack8(e);
            }
    }
};

constexpr int LRU_XS = 272;
constexpr int LRU_AP = 132;
template <bool FINAL>
__device__ __forceinline__ void lru_phase(const Params& p, LAS unsigned char* lds, int bid, int G) {
    int tid_ = threadIdx.x; asm volatile("" : "+v"(tid_));
    const int tid = tid_, wid = tid >> 6, lane = tid & 63, fr = lane & 15, fq = lane >> 4;
    LAS unsigned char* Xs = lds;
    LAS float* AF = (LAS float*)(lds + 64 * LRU_XS);
    LAS float* UF = AF + 64 * LRU_AP; LAS float* AB = UF + 64 * LRU_AP; LAS float* UB = AB + 64 * LRU_AP;
    const bf16_t* zx = (const bf16_t*)(p.ws + OFF_B); const bf16_t* zg = (const bf16_t*)(p.ws + OFF_C); bf16_t* yA = (bf16_t*)(p.ws + OFF_A);
    float* carP = (float*)(p.ws + OFF_CARP); float* carH = (float*)(p.ws + OFF_CARH);
    const bf16_t* WG = (const bf16_t*)p.ws + EWG;
    bf16x8 Bf[4][4]; float brf = 0.f, bif = 0.f, brb = 0.f, bib = 0.f, spf = 0.f, spb = 0.f; int blk_have = -1;
    for (int item = bid; item < 4096; item += G) {
        const int blk = item & 7, c = (item >> 3) & 63, b = item >> 9;
        const int t0 = c * 64; const size_t rowbase = (size_t)b * SEQ;
        if (blk != blk_have) {
            blk_have = blk;
            const bf16_t* wb = WG + (size_t)blk * 65536 + (size_t)(wid * 16 + fr) * 128 + fq * 8;
#pragma unroll
            for (int g = 0; g < 4; ++g)
#pragma unroll
                for (int ks = 0; ks < 4; ++ks) Bf[g][ks] = *(const bf16x8*)(wb + (size_t)g * 16384 + ks * 32);
            const int cgc = blk * 128 + wid * 16 + fr;
            brf = p.lru_br[cgc]; bif = p.lru_bi[cgc]; brb = p.lru_br[1024 + cgc]; bib = p.lru_bi[1024 + cgc];
            spf = 8.0f * log1pf(expf(-p.lru_lam[cgc])); spb = 8.0f * log1pf(expf(-p.lru_lam[1024 + cgc]));
        }
        float hin = 0.f;
        if (FINAL) {
            for (int i = tid; i < 4096; i += 512) {
                const int d = i >> 11, cc = (i >> 5) & 63, q4 = i & 31;
                const size_t gofs = ((size_t)(b * 2 + d) * 64 + cc) * 1024 + blk * 128 + q4 * 4;
                const f32x4 pv = *(const f32x4*)(carP + gofs), hv = *(const f32x4*)(carH + gofs);
                *(LAS f32x4*)((d ? AB : AF) + cc * LRU_AP + q4 * 4) = pv; *(LAS f32x4*)((d ? UB : UF) + cc * LRU_AP + q4 * 4) = hv;
            }
            __syncthreads();
            if (tid < 256) {
                const int dir = tid >> 7, ch = tid & 127;
                const LAS float* Pp = dir ? AB : AF; const LAS float* Hh = dir ? UB : UF;
                if (dir == 0) {
#pragma unroll 16
                    for (int c2 = 0; c2 < 64; ++c2) { const float pv = Pp[c2 * LRU_AP + ch], hv = Hh[c2 * LRU_AP + ch]; hin = (c2 < c) ? pv * hin + hv : hin; }
                } else {
#pragma unroll 16
                    for (int c2 = 63; c2 >= 0; --c2) { const float pv = Pp[c2 * LRU_AP + ch], hv = Hh[c2 * LRU_AP + ch]; hin = (c2 > c) ? pv * hin + hv : hin; }
                }
            }
            __syncthreads();
        }
        { const int tok = tid >> 3, cs = tid & 7, cg0 = blk * 128 + cs * 16;
          float y[16];
#pragma unroll
          for (int q = 0; q < 4; ++q) { const float4 bv = *(const float4*)(p.conv_b + cg0 + 4 * q); y[4 * q] = bv.x; y[4 * q + 1] = bv.y; y[4 * q + 2] = bv.z; y[4 * q + 3] = bv.w; }
#pragma unroll
          for (int k = 0; k < 4; ++k) {
              const int t = t0 + tok + k - 2;
              if (t >= 0 && t < SEQ) {
                  const u32x4* zp = (const u32x4*)(zx + (rowbase + t) * DM + cg0);
                  float z[16]; { float e[8]; unpack8(zp[0], e);
#pragma unroll
                      for (int j = 0; j < 8; ++j) z[j] = e[j];
                      unpack8(zp[1], e);
#pragma unroll
                      for (int j = 0; j < 8; ++j) z[8 + j] = e[j]; }
#pragma unroll
                  for (int q = 0; q < 4; ++q) { const float4 wv = *(const float4*)(p.conv_w + k * 1024 + cg0 + 4 * q);
                      y[4 * q] += wv.x * z[4 * q]; y[4 * q + 1] += wv.y * z[4 * q + 1]; y[4 * q + 2] += wv.z * z[4 * q + 2]; y[4 * q + 3] += wv.w * z[4 * q + 3]; }
              }
          }
          float e0[8], e1[8];
#pragma unroll
          for (int j = 0; j < 8; ++j) { e0[j] = y[j]; e1[j] = y[8 + j]; }
          LAS u32x4* xd = (LAS u32x4*)(Xs + tok * LRU_XS + cs * 32);
          xd[0] = pack8(e0); xd[1] = pack8(e1);
        }
        __syncthreads();
        { const int ch = wid * 16 + fr;
#pragma unroll
          for (int m = 0; m < 4; ++m) {
              bf16x8 Af[4];
#pragma unroll
              for (int ks = 0; ks < 4; ++ks) Af[ks] = *(const LAS bf16x8*)(Xs + (16 * m + fr) * LRU_XS + (ks * 32 + fq * 8) * 2);
              f32x4 acc[4];
#pragma unroll
              for (int g = 0; g < 4; ++g) { acc[g] = (f32x4){0.f, 0.f, 0.f, 0.f};
#pragma unroll
                  for (int ks = 0; ks < 4; ++ks) acc[g] = __builtin_amdgcn_mfma_f32_16x16x32_bf16(Af[ks], Bf[g][ks], acc[g], 0, 0, 0); }
#pragma unroll
              for (int j = 0; j < 4; ++j) {
                  const int tok = 16 * m + 4 * fq + j;
                  const float x = bf2f(*(const LAS bf16_t*)(Xs + tok * LRU_XS + ch * 2));
#pragma unroll
                  for (int d = 0; d < 2; ++d) {
                      const float r = fsigmoid(acc[2 * d][j] + (d ? brb : brf)), gi = fsigmoid(acc[2 * d + 1][j] + (d ? bib : bif));
                      const float la = -r * (d ? spb : spf);
                      const float a = __expf(la);
                      const float e2 = 2.0f * la;
                      const float om = (e2 > -0.125f) ? -e2 * (1.0f + e2 * (0.5f + e2 * (0.16666667f + e2 * (0.041666668f + e2 * 0.0083333338f)))) : 1.0f - a * a;
                      const float uu = sqrtf(om) * (gi * x);
                      (d ? AB : AF)[tok * LRU_AP + ch] = a; (d ? UB : UF)[tok * LRU_AP + ch] = uu;
                  }
              }
          }
        }
        __syncthreads();
        if (tid < 256) {
            const int dir = tid >> 7, ch = tid & 127, cgl = blk * 128 + ch;
            LAS float* Aa = dir ? AB : AF; LAS float* Uu = dir ? UB : UF;
            const size_t cb = ((size_t)(b * 2 + dir) * 64) * 1024 + cgl;
            float h = hin, P = 1.f;
            if (dir == 0) {
#pragma unroll 8
                for (int t = 0; t < 64; ++t) { const float a = Aa[t * LRU_AP + ch], uu = Uu[t * LRU_AP + ch]; h = a * h + uu; if (FINAL) Uu[t * LRU_AP + ch] = h; else P *= a; }
            } else {
#pragma unroll 8
                for (int t = 63; t >= 0; --t) { const float a = Aa[t * LRU_AP + ch], uu = Uu[t * LRU_AP + ch]; h = a * h + uu; if (FINAL) Uu[t * LRU_AP + ch] = h; else P *= a; }
            }
            if (!FINAL) { carP[cb + (size_t)c * 1024] = P; carH[cb + (size_t)c * 1024] = h; }
        }
        if (FINAL) {
            __syncthreads();
            const int tok = tid >> 3, cs = tid & 7, cg0 = blk * 128 + cs * 16; const size_t row = rowbase + t0 + tok;
            const u32x4* gp = (const u32x4*)(zg + row * DM + cg0);
            u32x4* yp = (u32x4*)(yA + row * DM + cg0);
#pragma unroll
            for (int hh = 0; hh < 2; ++hh) {
                float g[8], e[8]; unpack8(gp[hh], g);
                const f32x4 f0 = *(const LAS f32x4*)(UF + tok * LRU_AP + cs * 16 + hh * 8), f1 = *(const LAS f32x4*)(UF + tok * LRU_AP + cs * 16 + hh * 8 + 4);
                const f32x4 b0 = *(const LAS f32x4*)(UB + tok * LRU_AP + cs * 16 + hh * 8), b1 = *(const LAS f32x4*)(UB + tok * LRU_AP + cs * 16 + hh * 8 + 4);
#pragma unroll
                for (int j = 0; j < 4; ++j) { e[j] = (f0[j] + b0[j]) * g[j]; e[4 + j] = (f1[j] + b1[j]) * g[4 + j]; }
                yp[hh] = pack8(e);
            }
        }
    }
    __syncthreads();
}

namespace att {
constexpr int KVBLK = 64;
constexpr float SCALE = 0.07216878364870322f;
constexpr float THR = 8.f;
#ifndef ATT_SDEPTH
#define ATT_SDEPTH 1
#endif
constexpr int SDEPTH = ATT_SDEPTH;
constexpr int SHM_V = 64 * 128 * 2, SHM_K = 64 * 192 * 2;
#define ATT_KSWZ(row, colB) ((row) * 384 + ((colB) ^ (((row) & 7) << 4)))
#define ATT_SBAR() __builtin_amdgcn_sched_barrier(0)
__device__ __forceinline__ int crow(int r, int hi) { return (r & 3) + 8 * (r >> 2) + 4 * hi; }
__device__ __forceinline__ void partialSM(f32x16& p0, f32x16& p1, float& m_reg, float& mn, float& alpha) {
    constexpr float C = SCALE * 1.4426950408889634f;
    float pmax = p0[0];
#pragma unroll
    for (int r = 1; r < 16; ++r) pmax = fmaxf(pmax, p0[r]);
#pragma unroll
    for (int r = 0; r < 16; ++r) pmax = fmaxf(pmax, p1[r]);
    { auto rr = __builtin_amdgcn_permlane32_swap(__float_as_uint(pmax), __float_as_uint(pmax), false, false);
      pmax = fmaxf(__uint_as_float(rr[0]), __uint_as_float(rr[1])); }
    if (__builtin_expect(__all(pmax - m_reg <= THR / SCALE), 1)) { mn = m_reg; alpha = 1.f; }
    else { mn = fmaxf(m_reg, pmax); alpha = __builtin_amdgcn_exp2f((m_reg - mn) * C); m_reg = mn; }
    const float mnC = -mn * C;
#pragma unroll
    for (int r = 0; r < 16; ++r) p0[r] = fmaf(p0[r], C, mnC);
#pragma unroll
    for (int r = 0; r < 16; ++r) p1[r] = fmaf(p1[r], C, mnC);
#pragma unroll
    for (int r = 0; r < 16; ++r) p0[r] = __builtin_amdgcn_exp2f(p0[r]);
}
__device__ __forceinline__ void finishSM(f32x16& p0, f32x16& p1, float alpha, float& l_reg, bf16x8& pa0, bf16x8& pa1, bf16x8& pa2, bf16x8& pa3) {
#pragma unroll
    for (int r = 0; r < 16; ++r) p1[r] = __builtin_amdgcn_exp2f(p1[r]);
    float ps = 0;
#pragma unroll
    for (int r = 0; r < 16; ++r) ps += p0[r];
#pragma unroll
    for (int r = 0; r < 16; ++r) ps += p1[r];
    { auto rr = __builtin_amdgcn_permlane32_swap(__float_as_uint(ps), __float_as_uint(ps), false, false);
      ps = __uint_as_float(rr[0]) + __uint_as_float(rr[1]); }
    l_reg = l_reg * alpha + ps;
#define ATT_PK4(P, BASE, OUT) do { unsigned a0 = cvt_pk_bf16(P[BASE + 0], P[BASE + 1]), a1 = cvt_pk_bf16(P[BASE + 2], P[BASE + 3]);   \
    unsigned b0 = cvt_pk_bf16(P[BASE + 4], P[BASE + 5]), b1 = cvt_pk_bf16(P[BASE + 6], P[BASE + 7]);                              \
    auto r0 = __builtin_amdgcn_permlane32_swap(a0, b0, false, false); auto r1 = __builtin_amdgcn_permlane32_swap(a1, b1, false, false); \
    u32x4 w = {r0[0], r1[0], r0[1], r1[1]}; OUT = *reinterpret_cast<bf16x8*>(&w); } while (0)
    ATT_PK4(p0, 0, pa0); ATT_PK4(p0, 8, pa1); ATT_PK4(p1, 0, pa2); ATT_PK4(p1, 8, pa3);
#undef ATT_PK4
}
__device__ __forceinline__ void qkt(f32x16& p0, f32x16& p1, const char* Ks, const bf16x8* qr, int r32, int hi) {
    p0 = f32x16{}; p1 = f32x16{};
#pragma unroll
    for (int d0 = 0; d0 < 12; ++d0) { const int cb = (d0 * 16 + hi * 8) * 2;
        const bf16x8 b0 = *reinterpret_cast<const bf16x8*>(Ks + ATT_KSWZ(r32, cb));
        const bf16x8 b1 = *reinterpret_cast<const bf16x8*>(Ks + ATT_KSWZ(32 + r32, cb));
        p0 = __builtin_amdgcn_mfma_f32_32x32x16_bf16(b0, qr[d0], p0, 0, 0, 0);
        p1 = __builtin_amdgcn_mfma_f32_32x32x16_bf16(b1, qr[d0], p1, 0, 0, 0); }
}
__device__ __forceinline__ int v_st(int k, int c) { const int kk = (k & ~0xC) | ((k & 4) << 1) | ((k & 8) >> 1); return ((kk >> 3) * 4 + (c >> 5)) * 512 + ((kk & 7) * 32 + (c & 31)) * 2; }
__device__ __forceinline__ int v_rd_base(int lane) { return ((lane & 3) << 3) | (((lane >> 2) & 3) << 6) | (((lane >> 4) & 1) << 5) | (((lane >> 5) & 1) << 8); }
constexpr int v_rd_off(int d0, int ks, int half) { return d0 * 512 + ks * 4096 + half * 2048; }
template <int OFF> __device__ __forceinline__ s16x4 tr_read(int vb) {
    s16x4 r; asm volatile("ds_read_b64_tr_b16 %0, %1 offset:%2" : "=&v"(r) : "v"(vb), "i"(OFF) : "memory"); return r;
}
template <int D0> __device__ __forceinline__ void pv_one(f32x16& od, int vb, bf16x8 pa0, bf16x8 pa1, bf16x8 pa2, bf16x8 pa3) {
    const s16x4 l0 = tr_read<v_rd_off(D0, 0, 0)>(vb), h0 = tr_read<v_rd_off(D0, 0, 1)>(vb), l1 = tr_read<v_rd_off(D0, 1, 0)>(vb), h1 = tr_read<v_rd_off(D0, 1, 1)>(vb);
    const s16x4 l2 = tr_read<v_rd_off(D0, 2, 0)>(vb), h2 = tr_read<v_rd_off(D0, 2, 1)>(vb), l3 = tr_read<v_rd_off(D0, 3, 0)>(vb), h3 = tr_read<v_rd_off(D0, 3, 1)>(vb);
    asm volatile("s_waitcnt lgkmcnt(0)" ::: "memory"); ATT_SBAR();
#define ATT_PK(L, H) (bf16x8){L[0], L[1], L[2], L[3], H[0], H[1], H[2], H[3]}
    od = __builtin_amdgcn_mfma_f32_32x32x16_bf16(pa0, ATT_PK(l0, h0), od, 0, 0, 0);
    od = __builtin_amdgcn_mfma_f32_32x32x16_bf16(pa1, ATT_PK(l1, h1), od, 0, 0, 0);
    od = __builtin_amdgcn_mfma_f32_32x32x16_bf16(pa2, ATT_PK(l2, h2), od, 0, 0, 0);
    od = __builtin_amdgcn_mfma_f32_32x32x16_bf16(pa3, ATT_PK(l3, h3), od, 0, 0, 0);
#undef ATT_PK
}
__device__ __forceinline__ void pv_d0(f32x16* o, int vb, bf16x8 pa0, bf16x8 pa1, bf16x8 pa2, bf16x8 pa3) {
    pv_one<0>(o[0], vb, pa0, pa1, pa2, pa3); pv_one<1>(o[1], vb, pa0, pa1, pa2, pa3); pv_one<2>(o[2], vb, pa0, pa1, pa2, pa3); pv_one<3>(o[3], vb, pa0, pa1, pa2, pa3);
}
__device__ __forceinline__ void body(const bf16_t* Qn, const bf16_t* Qr, const bf16_t* __restrict__ Kh, const bf16_t* __restrict__ Vh, const bf16_t* __restrict__ Kp, bf16_t* Ob, const int* __restrict__ posq, const float* __restrict__ invf, char* lds) {
    int tid_ = threadIdx.x; asm volatile("" : "+v"(tid_));
    const int tid = tid_, wid = tid >> 6, lane = tid & 63, r32 = lane & 31, hi = lane >> 5;
    char* V_lds = lds; char* K_lds = lds + 2 * SHM_V;
    float* ws = (float*)(lds + 2 * SHM_V + 2 * SHM_K) + wid * 64; float* li_l = ws; float* al_l = ws + 32;
    float m_reg = -1e30f, l_reg = 0; f32x16 o[4] = {}; bf16x8 qr[12];
    { const bf16_t* qa = Qn + (size_t)(wid * 32 + r32) * 1024 + hi * 8; const bf16_t* qb = Qr + (size_t)(wid * 32 + r32) * 512 + hi * 8;
#pragma unroll
      for (int d0 = 0; d0 < 8; ++d0) qr[d0] = *reinterpret_cast<const bf16x8*>(qa + d0 * 16);
#pragma unroll
      for (int d0 = 0; d0 < 4; ++d0) qr[8 + d0] = *reinterpret_cast<const bf16x8*>(qb + d0 * 16); }
    {
        const float posf = (float)posq[wid * 32 + r32];
#pragma unroll
        for (int t = 0; t < 2; ++t) {
            const f32x4 fa = *(const f32x4*)(invf + 16 * t + 8 * hi), fb = *(const f32x4*)(invf + 16 * t + 8 * hi + 4);
            float x1[8], x2[8], o1[8], o2[8];
            unpack8(*reinterpret_cast<const u32x4*>(&qr[8 + t]), x1); unpack8(*reinterpret_cast<const u32x4*>(&qr[10 + t]), x2);
#pragma unroll
            for (int j = 0; j < 8; ++j) { float cs, sn; rope_cs(posf * (j < 4 ? fa[j] : fb[j - 4]), cs, sn); o1[j] = x1[j] * cs - x2[j] * sn; o2[j] = x2[j] * cs + x1[j] * sn; }
            const u32x4 w1 = pack8(o1), w2 = pack8(o2);
            qr[8 + t] = *reinterpret_cast<const bf16x8*>(&w1); qr[10 + t] = *reinterpret_cast<const bf16x8*>(&w2);
        }
    }
    const int sr = tid >> 4, sc = (tid & 15) * 8, vst0 = v_st(sr, sc), vst1 = v_st(32 + sr, sc);
    const int pr = tid >> 3, pc = (tid & 7) * 8;
    const int vb0 = (int)(uintptr_t)V_lds + v_rd_base(lane);
    struct { bf16x8 vs0, vs1, ks0, ks1, kp; } sr_[SDEPTH];
#define ATT_SLOAD(i, k0) do { sr_[i].vs0 = *(const bf16x8*)(&Vh[(size_t)((k0) + sr) * 1024 + sc]); sr_[i].vs1 = *(const bf16x8*)(&Vh[(size_t)((k0) + 32 + sr) * 1024 + sc]); \
    sr_[i].ks0 = *(const bf16x8*)(&Kh[(size_t)((k0) + sr) * 1024 + sc]); sr_[i].ks1 = *(const bf16x8*)(&Kh[(size_t)((k0) + 32 + sr) * 1024 + sc]); \
    sr_[i].kp = *(const bf16x8*)(&Kp[(size_t)((k0) + pr) * 64 + pc]); } while (0)
#define ATT_SWRITE(b, i) do { *(bf16x8*)(V_lds + (b) * SHM_V + vst0) = sr_[i].vs0; *(bf16x8*)(V_lds + (b) * SHM_V + vst1) = sr_[i].vs1; const int kc = sc * 2; \
    *(bf16x8*)(K_lds + (b) * SHM_K + ATT_KSWZ(sr, kc)) = sr_[i].ks0; *(bf16x8*)(K_lds + (b) * SHM_K + ATT_KSWZ(32 + sr, kc)) = sr_[i].ks1; \
    *(bf16x8*)(K_lds + (b) * SHM_K + ATT_KSWZ(pr, 256 + pc * 2)) = sr_[i].kp; } while (0)
#define ATT_SWAIT() do { if constexpr (SDEPTH == 2) asm volatile("s_waitcnt vmcnt(5)" ::: "memory"); else asm volatile("s_waitcnt vmcnt(0)" ::: "memory"); } while (0)
#define ATT_RESC(a) do { if (__any((a) < 1.f)) { if (hi == 0) al_l[r32] = (a); asm volatile("s_waitcnt lgkmcnt(0)" ::: "memory"); \
    _Pragma("unroll") for (int d = 0; d < 4; ++d) _Pragma("unroll") for (int r = 0; r < 16; ++r) o[d][r] *= al_l[crow(r, hi)]; } } while (0)
    f32x16 pA0, pA1, pB0, pB1; float mnA, mnB, alA, alB; bf16x8 pa0, pa1, pa2, pa3; constexpr int NT = SEQ / KVBLK;
    constexpr int SE = 0, SO = SDEPTH - 1;
    ATT_SLOAD(SE, 0); asm volatile("s_waitcnt vmcnt(0)" ::: "memory"); ATT_SWRITE(0, SE); __syncthreads();
    qkt(pA0, pA1, K_lds, qr, r32, hi); partialSM(pA0, pA1, m_reg, mnA, alA);
    ATT_SLOAD(SO, KVBLK); if constexpr (SDEPTH == 2) ATT_SLOAD(SE, 2 * KVBLK);
    ATT_SWAIT(); ATT_SWRITE(1, SO); __syncthreads();
    for (int j = 1; j + 1 < NT; j += 2) {
        ATT_SBAR(); qkt(pB0, pB1, K_lds + SHM_K, qr, r32, hi);
        finishSM(pA0, pA1, alA, l_reg, pa0, pa1, pa2, pa3); ATT_SBAR();
        ATT_SLOAD(SO, (j + SDEPTH) * KVBLK); ATT_SBAR();
        pv_d0(o, vb0, pa0, pa1, pa2, pa3); partialSM(pB0, pB1, m_reg, mnB, alB);
        __syncthreads(); ATT_SWAIT(); ATT_SWRITE(0, SE);
        ATT_RESC(alB); __syncthreads();
        ATT_SBAR(); qkt(pA0, pA1, K_lds, qr, r32, hi);
        finishSM(pB0, pB1, alB, l_reg, pa0, pa1, pa2, pa3); ATT_SBAR();
        if (SDEPTH == 1 || j + 3 < NT) ATT_SLOAD(SE, (j + 1 + SDEPTH) * KVBLK); ATT_SBAR();
        pv_d0(o, vb0 + SHM_V, pa0, pa1, pa2, pa3); partialSM(pA0, pA1, m_reg, mnA, alA);
        __syncthreads(); ATT_SWAIT(); ATT_SWRITE(1, SO);
        ATT_RESC(alA); __syncthreads();
    }
    ATT_SBAR(); qkt(pB0, pB1, K_lds + SHM_K, qr, r32, hi);
    finishSM(pA0, pA1, alA, l_reg, pa0, pa1, pa2, pa3); ATT_SBAR();
    pv_d0(o, vb0, pa0, pa1, pa2, pa3); partialSM(pB0, pB1, m_reg, mnB, alB);
    __syncthreads(); ATT_RESC(alB);
    finishSM(pB0, pB1, alB, l_reg, pa0, pa1, pa2, pa3); ATT_SBAR();
    pv_d0(o, vb0 + SHM_V, pa0, pa1, pa2, pa3);
    if (hi == 0) li_l[r32] = l_reg; asm volatile("s_waitcnt lgkmcnt(0)" ::: "memory");
    float rli[16];
#pragma unroll
    for (int r = 0; r < 16; ++r) rli[r] = __builtin_amdgcn_rcpf(li_l[crow(r, hi)]);
    bf16_t* Ow = Ob + (size_t)(wid * 32) * 1024;
#pragma unroll
    for (int r = 0; r < 16; ++r) { const int orow = crow(r, hi);
#pragma unroll
        for (int d0 = 0; d0 < 4; ++d0) Ow[(size_t)orow * 1024 + d0 * 32 + r32] = f2bf(o[d0][r] * rli[r]); }
#undef ATT_SLOAD
#undef ATT_SWRITE
#undef ATT_SWAIT
#undef ATT_RESC
}
}

__device__ __forceinline__ void attn_phase(const Params& p, char* smem, int bid, int G) {
    bf16_t* Qn = (bf16_t*)(p.ws + OFF_A); const bf16_t* Qr = (const bf16_t*)(p.ws + OFF_QR);
    const bf16_t* Kn = (const bf16_t*)(p.ws + OFF_C); const bf16_t* V = (const bf16_t*)(p.ws + OFF_D); const bf16_t* Kp = (const bf16_t*)(p.ws + OFF_KPE);
    for (int u = bid; u < 1024; u += G) {
        const int qb = u & 15, h = (u >> 4) & 7, b = u >> 7;
        const size_t r0 = (size_t)b * SEQ, q0 = r0 + (size_t)qb * 256;
        __syncthreads();
        att::body(Qn + q0 * 1024 + 128 * h, Qr + q0 * 512 + 64 * h, Kn + r0 * 1024 + 128 * h, V + r0 * 1024 + 128 * h, Kp + r0 * 64, Qn + q0 * 1024 + 128 * h, p.pos + q0, (const float*)(p.ws + OFF_INVF), smem);
    }
    __syncthreads();
}

__device__ __forceinline__ void phase_prep(const Params& p, LAS unsigned char* lds, int gw, int nw, int wid, int lane) {
    bf16_t* W = (bf16_t*)p.ws;
    WtCtx c{(LAS float*)(lds + wid * 8448), gw, nw, lane, 0};
#pragma unroll 1
    for (int f = 0; f < 2; ++f) {
        const float* wg = f ? p.ffn2_wg : p.ffn1_wg; const float* wu = f ? p.ffn2_wu : p.ffn1_wu; const float* wd = f ? p.ffn2_wd : p.ffn1_wd;
        bf16_t* gu = W + (f ? EW2GU : EW1GU); bf16_t* dn = W + (f ? EW2D : EW1D);
        const float* ks = f ? p.ffn2_norm : nullptr;
        wt_job(c, wg, 1024, 2816, 0, 2816, gu, 1024, 0, 128, 256, ks);
        wt_job(c, wu, 1024, 2816, 0, 2816, gu, 1024, 128, 128, 256, ks);
        wt_job(c, wd, 2816, 1024, 0, 1024, dn, 2816, 0, 1024, 0);
    }
    { bf16_t* Win = W + EWIN;
      wt_job(c, p.w_in, 1024, 4800, 0, 1024, Win, 1024, 0, 1024, 0, p.mix_norm);
      wt_job(c, p.w_in, 1024, 4800, 1024, 1024, Win, 1024, 1024, 1024, 0, p.mix_norm);
      wt_job(c, p.w_in, 1024, 4800, 2432, 256, Win, 1024, 2048, 256, 0, p.mix_norm);
      wt_job(c, p.w_in, 1024, 4800, 2048, 384, Win, 1024, 2304, 384, 0, p.mix_norm);
      wt_job(c, p.w_in, 1024, 4800, 2688, 64, Win, 1024, 2688, 64, 0, p.mix_norm);
      wt_job(c, p.w_in, 1024, 4800, 2752, 1024, Win, 1024, 2816, 1024, 0, p.mix_norm);
      wt_job(c, p.w_in, 1024, 4800, 3776, 1024, Win, 1024, 3840, 1024, 0, p.mix_norm);
      const int gt = gw * 64 + lane;
      for (int i = gt; i < 8192; i += nw * 64) ((u32x4*)(Win + 2752 * 1024))[i] = (u32x4){0u, 0u, 0u, 0u};
    }
#pragma unroll 1
    for (int db = 0; db < 16; ++db) {
        const int dir = db >> 3, blk = db & 7;
        wt_job(c, p.lru_wr + (size_t)db * 16384, 128, 128, 0, 128, W + EWG + (size_t)blk * 65536, 128, dir * 256, 128, 0);
        wt_job(c, p.lru_wi + (size_t)db * 16384, 128, 128, 0, 128, W + EWG + (size_t)blk * 65536, 128, dir * 256 + 128, 128, 0);
    }
#pragma unroll 1
    for (int h = 0; h < 8; ++h) {
        wt_job(c, p.w_uq, 384, 1536, 192 * h, 128, W + EWUQ, 384, 128 * h, 128, 0);
        wt_job(c, p.w_uq, 384, 1536, 192 * h + 128, 32, W + EWUQ, 384, 1024 + 256 * (h >> 2) + 32 * (h & 3), 32, 0);
        wt_job(c, p.w_uq, 384, 1536, 192 * h + 160, 32, W + EWUQ, 384, 1024 + 256 * (h >> 2) + 128 + 32 * (h & 3), 32, 0);
    }
    wt_job(c, p.w_ukv, 256, 2048, 0, 2048, W + EWUKV, 256, 0, 2048, 0);
    wt_job(c, p.w_lru_out, 1024, 1024, 0, 1024, W + EWLO, 1024, 0, 1024, 0);
    wt_job(c, p.w_mla_out, 1024, 1024, 0, 1024, W + EWMO, 1024, 0, 1024, 0);
    wt_job(c, p.w_o, 1024, 1024, 0, 1024, W + EWO, 1024, 0, 1024, 0);
    wt_job(c, p.ple_wg, 1024, 1024, 0, 1024, W + EWPG, 1024, 0, 1024, 0, p.ple_norm);
    wt_job(c, p.ple_wp, 256, 1024, 0, 1024, W + EWPP, 256, 0, 1024, 0);
    if (gw == 0 && lane == 0) { float* t = (float*)(p.ws + OFF_INVF);
#pragma unroll
        for (int i = 0; i < 32; ++i) t[i] = p.inv_freq[i]; }
    { float* rs = (float*)(p.ws + OFF_RS); for (int i = gw * 64 + lane; i < 3 * MT; i += nw * 64) rs[i] = 0.f; }
    norm_rows(p.x, p.ffn1_norm, (bf16_t*)(p.ws + OFF_A), gw, nw, lane);
}

template <class Epi> __device__ __forceinline__ void run_gemm(LAS unsigned char* lds, const bf16_t* A, const bf16_t* Bt, int N, int K, const Epi E, int bid, int G) {
    pg8::Gemm g{A, Bt, MT, N, K}; pg8::StaticOrder S; S.init(MT, N, G, bid);
    pg8::gemm_phase<Epi, pg8::StaticOrder, false>(lds, g, S, E, nullptr);
}

__device__ __forceinline__ void run_phase(const Params& p, int ph, unsigned char* smem) {
    LAS unsigned char* lds = (LAS unsigned char*)smem;
    int tid_ = threadIdx.x; asm volatile("" : "+v"(tid_));
    int bid = blockIdx.x, G = gridDim.x; asm volatile("" : "+s"(bid), "+s"(G));
    const int tid = tid_, wid = tid >> 6, lane = tid & 63, nw = G * 8, gw = bid * 8 + wid;
    unsigned char* ws = p.ws; const bf16_t* W = (const bf16_t*)ws;
    bf16_t* bA = (bf16_t*)(ws + OFF_A); bf16_t* bD = (bf16_t*)(ws + OFF_D);
#ifndef PH_MASK
#define PH_MASK 0x3ffff
#endif
#define PH_ON(k) constexpr (((PH_MASK) >> (k)) & 1)
    switch (ph) {
    case 0: if PH_ON(0) phase_prep(p, lds, gw, nw, wid, lane); break;
    case 1: case 13: if PH_ON(1) {
        if (ph == 13) { bf16_t* pb = (bf16_t*)(ws + OFF_F);
            for (int i = gw * 64 + lane; i < MT * 256 / 8; i += nw * 64) { const float4 a = ((const float4*)p.p)[2 * i], b = ((const float4*)p.p)[2 * i + 1];
                const float e[8] = {a.x, a.y, a.z, a.w, b.x, b.y, b.z, b.w}; ((u32x4*)pb)[i] = pack8(e); } }
        EpiSwiGLU E{(bf16_t*)(ws + OFF_B), ph == 13 ? (const float*)(ws + OFF_RS) + MT : nullptr}; run_gemm(lds, bA, W + (ph == 1 ? EW1GU : EW2GU), 5632, 1024, E, bid, G); } break;
    case 2: case 14: if PH_ON(2) { EpiResid E{ph == 2 ? p.x : p.out, p.out, bA, (float*)(ws + OFF_RS) + (ph == 2 ? 0 : 2 * MT), 0.5f, 0.f}; run_gemm(lds, (const bf16_t*)(ws + OFF_B), W + (ph == 2 ? EW1D : EW2D), 1024, 2816, E, bid, G); } break;
    case 3: if PH_ON(3) norm_rows(p.out, p.mix_norm, bA, gw, nw, lane); break;
    case 4: if PH_ON(4) { EpiWin E{ws, (const float*)(ws + OFF_RS)}; run_gemm(lds, bA, W + EWIN, 4864, 1024, E, bid, G); } break;
    case 5: if PH_ON(5) { lru_phase<false>(p, lds, bid, G); mid_rows(p, gw, nw, lane); } break;
    case 6: if PH_ON(6) lru_phase<true>(p, lds, bid, G); break;
    case 7: if PH_ON(7) { EpiGateMul E{bD, bD, (bf16_t*)(ws + OFF_B), 0}; run_gemm(lds, bA, W + EWLO, 1024, 1024, E, bid, G); } break;
    case 8: if PH_ON(8) { EpiQ Eq{bA, (bf16_t*)(ws + OFF_QR)}; run_gemm(lds, (const bf16_t*)(ws + OFF_CQN), W + EWUQ, 1536, 384, Eq, bid, G);
              EpiKV Ek{(bf16_t*)(ws + OFF_C), (bf16_t*)(ws + OFF_D)}; run_gemm(lds, (const bf16_t*)(ws + OFF_CKVN), W + EWUKV, 2048, 256, Ek, bid, G); } break;
    case 9: if PH_ON(9) attn_phase(p, (char*)smem, bid, G); break;
    case 10: if PH_ON(10) { EpiGateMul E{(const bf16_t*)(ws + OFF_E), (const bf16_t*)(ws + OFF_B), (bf16_t*)(ws + OFF_C), 1}; run_gemm(lds, bA, W + EWMO, 1024, 1024, E, bid, G); } break;
    case 11: if PH_ON(11) { EpiResid E{p.out, p.out, bA, (float*)(ws + OFF_RS) + MT, 1.0f, 0.f}; run_gemm(lds, (const bf16_t*)(ws + OFF_C), W + EWO, 1024, 1024, E, bid, G); } break;
    case 12: if PH_ON(12) norm_rows(p.out, p.ffn2_norm, bA, gw, nw, lane); break;
    case 15: if PH_ON(15) { norm_rows(p.out, p.ple_norm, bA, gw, nw, lane);
               bf16_t* pb = (bf16_t*)(ws + OFF_F);
               for (int i = gw * 64 + lane; i < MT * 256 / 8; i += nw * 64) { const float4 a = ((const float4*)p.p)[2 * i], b = ((const float4*)p.p)[2 * i + 1];
                   const float e[8] = {a.x, a.y, a.z, a.w, b.x, b.y, b.z, b.w}; ((u32x4*)pb)[i] = pack8(e); } } break;
    case 16: if PH_ON(16) { EpiF32Act<1> Eg{(float*)(ws + OFF_B), (const float*)(ws + OFF_RS) + 2 * MT}; run_gemm(lds, bA, W + EWPG, 1024, 1024, Eg, bid, G);
               EpiF32Act<0> Ep{(float*)(ws + OFF_D), nullptr}; run_gemm(lds, (const bf16_t*)(ws + OFF_F), W + EWPP, 1024, 256, Ep, bid, G); } break;
    case 17: if PH_ON(17) final_rows(p, gw, nw, lane); break;
    default: break;
    }
}

typedef const __attribute__((address_space(4))) Params* KP;
#if defined(__HIP_DEVICE_COMPILE__)
#define MK_PHASE(k) do { KP q = (KP)__builtin_amdgcn_kernarg_segment_ptr(); asm volatile("" : "+s"(q)); const Params lp = *q; run_phase(lp, (k), smem); } while (0)
#else
#define MK_PHASE(k) do { (void)smem; } while (0)
#endif
#if MK_ONE_LAUNCH
__device__ __forceinline__ void grid_bar(unsigned* ctr, unsigned target) {
    asm volatile("s_waitcnt vmcnt(0) lgkmcnt(0)" ::: "memory");
    __syncthreads();
    if (threadIdx.x == 0) {
        __builtin_amdgcn_fence(__ATOMIC_RELEASE, "agent");
        asm volatile("s_waitcnt vmcnt(0)" ::: "memory");
        __hip_atomic_fetch_add(ctr, 1u, __ATOMIC_RELAXED, __HIP_MEMORY_SCOPE_AGENT);
        while (__hip_atomic_load(ctr, __ATOMIC_RELAXED, __HIP_MEMORY_SCOPE_AGENT) < target) __builtin_amdgcn_s_sleep(1);
        __builtin_amdgcn_fence(__ATOMIC_ACQUIRE, "agent");
        asm volatile("s_waitcnt vmcnt(0)" ::: "memory");
    }
    __syncthreads();
}
__global__ void __launch_bounds__(512, 2) mk(Params p_unused) {
    extern __shared__ __attribute__((aligned(16))) unsigned char smem[];
    cg::grid_group grid = cg::this_grid();
    unsigned* ctr = nullptr; unsigned G = gridDim.x;
#if defined(__HIP_DEVICE_COMPILE__)
    { KP q = (KP)__builtin_amdgcn_kernarg_segment_ptr(); ctr = (unsigned*)(q->ws + OFF_BAR); }
#endif
    unsigned bt = 0;
#define GB(k) grid_bar(ctr, (bt += G))
    if (blockIdx.x == 0 && threadIdx.x == 0) __hip_atomic_store(ctr, 0u, __ATOMIC_RELAXED, __HIP_MEMORY_SCOPE_AGENT);
    grid.sync();
    MK_PHASE(0); GB(1); MK_PHASE(1); GB(2); MK_PHASE(2); GB(3); MK_PHASE(4); GB(5); MK_PHASE(5); GB(6);
    MK_PHASE(6); GB(7); MK_PHASE(7); GB(8); MK_PHASE(8); GB(9); MK_PHASE(9); GB(10); MK_PHASE(10); GB(11); MK_PHASE(11); GB(12);
    MK_PHASE(13); GB(14); MK_PHASE(14); GB(15); MK_PHASE(16); GB(17); MK_PHASE(17);
#undef GB
}
#else
template <int PH> __global__ void __launch_bounds__(512, 2) mkp(Params p_unused) {
    extern __shared__ __attribute__((aligned(16))) unsigned char smem[];
    MK_PHASE(PH);
}
template <int PH> static void launch_phases(const Params& p, int grid, hipStream_t stream, bool setattr) {
    if constexpr (PH < NPHASE) {
        if (setattr) { if (hipFuncSetAttribute((const void*)mkp<PH>, hipFuncAttributeMaxDynamicSharedMemorySize, LDS_BYTES) != hipSuccess) fprintf(stderr, "kernel_launch: hipFuncSetAttribute failed (phase %d)\n", PH); }
        else {
#if defined(MK_DEBUG)
            if (PH == 9) hipLaunchKernelGGL(chk, dim3(1), dim3(64), 0, stream, p, 89);
            if (PH == 7) hipLaunchKernelGGL(chk, dim3(1), dim3(64), 0, stream, p, 70);
            if (PH == 10) hipLaunchKernelGGL(chk, dim3(1), dim3(64), 0, stream, p, 90);
            if (PH == 11) hipLaunchKernelGGL(chk, dim3(1), dim3(64), 0, stream, p, 91);
            if (PH == 14) hipLaunchKernelGGL(chk, dim3(1), dim3(64), 0, stream, p, 92);
            if (PH == 17) hipLaunchKernelGGL(chk, dim3(1), dim3(64), 0, stream, p, 93);
#endif
            hipLaunchKernelGGL(mkp<PH>, dim3(grid), dim3(512), LDS_BYTES, stream, p);
#if defined(MK_DEBUG)
            if (true) hipLaunchKernelGGL(chk, dim3(1), dim3(64), 0, stream, p, PH);
            if (PH == NPHASE - 1) hipLaunchKernelGGL(chk, dim3(1), dim3(64), 0, stream, p, MK_DEBUG);
#endif
        }
        launch_phases<PH + 1>(p, grid, stream, setattr);
    }
}
#endif

extern "C" void kernel_launch(void* const* d_in, const int* in_sizes, int n_in, void* d_out, int out_size, void* d_ws, size_t ws_size, hipStream_t stream) {
    static int grid = 0;
    if (grid == 0) {
        if (n_in != 32 || in_sizes[0] != MT * DM || out_size != MT * DM || ws_size < WS_NEED) {
            fprintf(stderr, "kernel_launch: unexpected shapes: n_in %d in0 %d out %d ws %zu (need %zu)\n", n_in, n_in > 0 ? in_sizes[0] : -1, out_size, ws_size, (size_t)WS_NEED); grid = -1; return; }
        int dev = 0, cus = 0, per_cu = 0;
        (void)hipGetDevice(&dev); (void)hipDeviceGetAttribute(&cus, hipDeviceAttributeMultiprocessorCount, dev);
#if MK_ONE_LAUNCH
        if (hipFuncSetAttribute((const void*)mk, hipFuncAttributeMaxDynamicSharedMemorySize, LDS_BYTES) != hipSuccess) { fprintf(stderr, "kernel_launch: hipFuncSetAttribute failed\n"); grid = -1; return; }
        if (hipOccupancyMaxActiveBlocksPerMultiprocessor(&per_cu, (const void*)mk, 512, LDS_BYTES) != hipSuccess || per_cu < 1) { fprintf(stderr, "kernel_launch: occupancy query gives %d\n", per_cu); per_cu = 1; }
#else
        { Params z{}; launch_phases<0>(z, 0, stream, true); }
#endif
        (void)hipGetLastError();
        grid = cus;
    }
    if (grid < 0) return;
    Params p{};
    p.x = (const float*)d_in[0]; p.p = (const float*)d_in[1]; p.pos = (const int*)d_in[2];
    p.ffn1_norm = (const float*)d_in[3]; p.ffn1_wg = (const float*)d_in[4]; p.ffn1_wu = (const float*)d_in[5]; p.ffn1_wd = (const float*)d_in[6];
    p.mix_norm = (const float*)d_in[7]; p.w_in = (const float*)d_in[8]; p.conv_w = (const float*)d_in[9]; p.conv_b = (const float*)d_in[10];
    p.lru_wr = (const float*)d_in[11]; p.lru_br = (const float*)d_in[12]; p.lru_wi = (const float*)d_in[13]; p.lru_bi = (const float*)d_in[14]; p.lru_lam = (const float*)d_in[15];
    p.w_lru_out = (const float*)d_in[16]; p.q_norm = (const float*)d_in[17]; p.w_uq = (const float*)d_in[18]; p.kv_norm = (const float*)d_in[19]; p.w_ukv = (const float*)d_in[20];
    p.w_mla_out = (const float*)d_in[21]; p.w_o = (const float*)d_in[22]; p.ffn2_norm = (const float*)d_in[23]; p.ffn2_wg = (const float*)d_in[24]; p.ffn2_wu = (const float*)d_in[25];
    p.ffn2_wd = (const float*)d_in[26]; p.ple_norm = (const float*)d_in[27]; p.ple_wg = (const float*)d_in[28]; p.ple_wp = (const float*)d_in[29]; p.ple_pn = (const float*)d_in[30];
    p.final_norm = (const float*)d_in[31];
    p.out = (float*)d_out; p.ws = (unsigned char*)d_ws;
    for (int i = 0; i < 32; ++i) p.inv_freq[i] = (float)pow(10000.0, -(double)(2 * i) / 64.0);
#if MK_ONE_LAUNCH
    void* args[] = {&p};
    hipError_t e = hipLaunchCooperativeKernel((const void*)mk, dim3(grid), dim3(512), args, LDS_BYTES, stream);
    if (e != hipSuccess) fprintf(stderr, "kernel_launch: cooperative launch failed: %s (grid %d)\n", hipGetErrorString(e), grid);
#else
    launch_phases<0>(p, grid, stream, false);
    hipError_t e = hipPeekAtLastError();
    if (e != hipSuccess) fprintf(stderr, "kernel_launch: launch failed: %s\n", hipGetErrorString(e));
#endif
}
```

```cpp
#include <hip/hip_runtime.h>
#include <hip/hip_cooperative_groups.h>
#include <cstdio>
#include <cmath>
namespace cg = cooperative_groups;
#ifndef MK_ONE_LAUNCH
#define MK_ONE_LAUNCH 1
#endif
namespace pg8 {
#define PG8_LAS __attribute__((address_space(3)))
typedef unsigned short bf16_t;
typedef short bf16x8 __attribute__((ext_vector_type(8)));
typedef float f32x4 __attribute__((ext_vector_type(4)));
typedef unsigned u32x4 __attribute__((ext_vector_type(4)));
constexpr int BM = 256, BK = 64, HALF = 128, HTB = HALF * BK * 2  , STAGE_BYTES = 8 * HTB, NXCD = 8, WGM = 8;

__host__ __device__ __forceinline__ int lds_byte(int r, int c) { const int st = (r >> 4) * 2 + (c >> 5), rr = r & 15, cc = c & 31, ob = rr * 64 + cc * 2; return st * 1024 + (ob ^ (((ob >> 9) & 1) << 5)); }
__host__ __device__ __forceinline__ void stage_rc(int b, int& R, int& C) { const int st = b / 1024, sb = b % 1024, swz = sb ^ (((sb >> 9) & 1) << 5); R = (st >> 1) * 16 + swz / 64; C = (st & 1) * 32 + (swz % 64) / 2; }
__host__ __device__ __forceinline__ int perm32(int rho) { const int n = rho >> 4, i = rho & 15; return 8 * (i >> 2) + 4 * n + (i & 3); }

struct Unit { int pm, pn; };
struct Gemm { const bf16_t* A; const bf16_t* Bt; int M, N, K; };

struct StaticOrder {
    int nM, nN, nwg, G, c;
    __host__ __device__ void init(int M, int N, int G_, int c_) { nM = M / BM; nN = N / BM; nwg = nM * nN; G = G_; c = c_; }
    __host__ __device__ bool next(int i, Unit& u) const {
        const long L = (long)i * G + c; if (L >= nwg) return false;
        int wgid = (int)L; { const int q = nwg / NXCD, r = nwg % NXCD, xcd = wgid % NXCD, off = wgid / NXCD; wgid = (xcd < r ? xcd * (q + 1) : r * (q + 1) + (xcd - r) * q) + off; }
        const int nig = WGM * nN, gid = wgid / nig, fm = gid * WGM, gsz = (nM - fm) < WGM ? (nM - fm) : WGM;
        u.pm = fm + ((wgid % nig) % gsz); u.pn = (wgid % nig) / gsz; return true;
    }
    __device__ __forceinline__ void a_ready(const Unit&) const {}
    __device__ __forceinline__ void done(const Unit&) const {}
};
typedef float cvt_f32x2 __attribute__((ext_vector_type(2)));
typedef __bf16 cvt_bf16x2 __attribute__((ext_vector_type(2)));
__device__ __forceinline__ unsigned cvt_pk_bf16(float lo, float hi) { const cvt_f32x2 v = {lo, hi}; const cvt_bf16x2 r = __builtin_convertvector(v, cvt_bf16x2); return __builtin_bit_cast(unsigned, r); }
typedef float f32x2 __attribute__((ext_vector_type(2)));
template <class Epi, class Sched, bool STAMP = false>
__device__ __forceinline__ void gemm_phase(PG8_LAS unsigned char* lds, const Gemm g, const Sched S, const Epi E, unsigned long long* stamps) {
    int tid_ = threadIdx.x; asm volatile("" : "+v"(tid_));
    const int tid = tid_, wid = __builtin_amdgcn_readfirstlane(tid >> 6), lane = tid & 63, wr = wid >> 2, wc = wid & 3, fr = lane & 15, fq = lane >> 4;
    const int K = g.K, nt = K / BK;
    int ts_lo = 0, ts_hi = 0, nts = 0; const unsigned long long rt_entry = STAMP ? (unsigned long long)wall_clock64() : 0ull;
#define PG8_STAMP() do { if (STAMP && wid == 0 && nts < 64) { const unsigned long long _c = (unsigned long long)clock64(); \
        ts_lo = (lane == nts) ? (int)(unsigned)_c : ts_lo; ts_hi = (lane == nts) ? (int)(unsigned)(_c >> 32) : ts_hi; ++nts; } } while (0)
    PG8_STAMP();
    unsigned voffA[2], voffB[2];
#pragma unroll
    for (int i = 0; i < 2; ++i) { int R, C; stage_rc(tid * 16 + i * 8192, R, C); const int Rb = Epi::PERM ? ((R & ~31) + perm32(R & 31)) : R;
        voffA[i] = (unsigned)(R * K + C) * 2u; voffB[i] = (unsigned)(Rb * K + C) * 2u; }
    const size_t kstep = (size_t)(BK * 2);
    const size_t hstep = (size_t)HALF * K * 2;
    const size_t tstep = 2 * hstep;
    const unsigned ldsw = (unsigned)wid * 1024u;
    const int aoff = lds_byte(wr * 64 + fr, fq * 8), boff = lds_byte(wc * 32 + fr, fq * 8);
#define PG8_SA(b, h) (((b) * 2 + (h)) * HTB)
#define PG8_SB(b, h) ((4 + (b) * 2 + (h)) * HTB)
#define PG8_STAGE(bufoff, gbase, voff) do { _Pragma("unroll") for (int _i = 0; _i < 2; ++_i) \
        __builtin_amdgcn_global_load_lds((const unsigned*)((const char*)(gbase) + (voff)[_i]), (PG8_LAS unsigned*)(lds + (bufoff) + ldsw + _i * 8192), 16, 0, 0); } while (0)
#define PG8_LDA(dst, b, h) do { _Pragma("unroll") for (int m = 0; m < 4; ++m) _Pragma("unroll") for (int k = 0; k < 2; ++k) dst[m][k] = *(const PG8_LAS bf16x8*)(lds + PG8_SA(b, h) + aoff + m * 2048 + k * 1024); } while (0)
#define PG8_LDB(dst, b, h) do { _Pragma("unroll") for (int n = 0; n < 2; ++n) _Pragma("unroll") for (int k = 0; k < 2; ++k) dst[n][k] = *(const PG8_LAS bf16x8*)(lds + PG8_SB(b, h) + boff + n * 2048 + k * 1024); } while (0)
#define PG8_MMA(ai, bj, At, Bt) do { __builtin_amdgcn_s_setprio(1); _Pragma("unroll") for (int m = 0; m < 4; ++m) _Pragma("unroll") for (int n = 0; n < 2; ++n) _Pragma("unroll") for (int k = 0; k < 2; ++k) \
        acc[ai][bj][m][n] = __builtin_amdgcn_mfma_f32_16x16x32_bf16(Bt[n][k], At[m][k], acc[ai][bj][m][n], 0, 0, 0); __builtin_amdgcn_s_setprio(0); } while (0)
#define PG8_WAIT_V(n) asm volatile("s_waitcnt vmcnt(" #n ")" ::: "memory")
#define PG8_WAIT_L(n) asm volatile("s_waitcnt lgkmcnt(" #n ")" ::: "memory")
#define PG8_BAR __builtin_amdgcn_s_barrier()
#define PG8_SCHED __builtin_amdgcn_sched_barrier(0)
    Unit cur, nxt; int ui = 0;
    if (!S.next(0, cur)) return;
    f32x4 acc[2][2][4][2];
#pragma unroll
    for (int a = 0; a < 2; ++a)
#pragma unroll
        for (int b = 0; b < 2; ++b)
#pragma unroll
            for (int m = 0; m < 4; ++m)
#pragma unroll
                for (int n = 0; n < 2; ++n) acc[a][b][m][n] = (f32x4){0.f, 0.f, 0.f, 0.f};
    bf16x8 At[4][2], B0[2][2], B1[2][2];
    const char* cA = (const char*)g.A + (size_t)cur.pm * tstep; const char* cB = (const char*)g.Bt + (size_t)cur.pn * tstep;
    S.a_ready(cur);
    PG8_STAGE(PG8_SB(0, 0), cB, voffB); PG8_STAGE(PG8_SA(0, 0), cA, voffA); PG8_STAGE(PG8_SB(0, 1), cB + hstep, voffB); PG8_STAGE(PG8_SA(0, 1), cA + hstep, voffA);
    if (wr == 1) PG8_BAR;
    PG8_WAIT_V(4); PG8_BAR;
    PG8_STAGE(PG8_SB(1, 0), cB + kstep, voffB); PG8_STAGE(PG8_SA(1, 0), cA + kstep, voffA); PG8_STAGE(PG8_SB(1, 1), cB + hstep + kstep, voffB);
    PG8_WAIT_V(6); PG8_BAR;
    PG8_STAMP();
    for (;;) {
        const bool has_next = S.next(ui + 1, nxt);
        const char* nA = has_next ? (const char*)g.A + (size_t)nxt.pm * tstep : cA; const char* nB = has_next ? (const char*)g.Bt + (size_t)nxt.pn * tstep : cB;
        for (int t = 0; t < nt; t += 2) {
            const bool last = (t == nt - 2);
            const char* a1 = cA + (size_t)(t + 1) * kstep;
            const char* a2 = last ? nA : cA + (size_t)(t + 2) * kstep; const char* b2 = last ? nB : cB + (size_t)(t + 2) * kstep;
            const char* a3 = a2 + kstep; const char* b3 = b2 + kstep;
            if (last && has_next) S.a_ready(nxt);
            PG8_LDB(B0, 0, 0); PG8_SCHED; PG8_LDA(At, 0, 0); PG8_STAGE(PG8_SA(1, 1), a1 + hstep, voffA);
            PG8_WAIT_L(8); PG8_BAR; PG8_WAIT_L(0); PG8_MMA(0, 0, At, B0); PG8_BAR; PG8_SCHED;
            PG8_LDB(B1, 0, 1); PG8_STAGE(PG8_SB(0, 0), b2, voffB);
            PG8_BAR; PG8_WAIT_L(0); PG8_MMA(0, 1, At, B1); PG8_BAR;
            PG8_LDA(At, 0, 1); PG8_STAGE(PG8_SA(0, 0), a2, voffA);
            PG8_BAR; PG8_WAIT_L(0); PG8_MMA(1, 0, At, B0); PG8_BAR; PG8_SCHED;
            PG8_STAGE(PG8_SB(0, 1), b2 + hstep, voffB);
            PG8_WAIT_V(6); PG8_BAR; PG8_MMA(1, 1, At, B1); PG8_BAR;
            PG8_LDB(B0, 1, 0); PG8_SCHED; PG8_LDA(At, 1, 0); PG8_STAGE(PG8_SA(0, 1), a2 + hstep, voffA);
            PG8_WAIT_L(8); PG8_BAR; PG8_WAIT_L(0); PG8_MMA(0, 0, At, B0); PG8_BAR; PG8_SCHED;
            PG8_LDB(B1, 1, 1); PG8_STAGE(PG8_SB(1, 0), b3, voffB);
            PG8_BAR; PG8_WAIT_L(0); PG8_MMA(0, 1, At, B1); PG8_BAR;
            PG8_LDA(At, 1, 1); PG8_STAGE(PG8_SA(1, 0), a3, voffA);
            PG8_BAR; PG8_WAIT_L(0); PG8_MMA(1, 0, At, B0); PG8_BAR; PG8_SCHED;
            PG8_STAGE(PG8_SB(1, 1), b3 + hstep, voffB);
            PG8_WAIT_V(6); PG8_BAR; PG8_MMA(1, 1, At, B1); PG8_BAR;
        }
        PG8_STAMP();
        if constexpr (!Epi::AFTER_DRAIN) { E(acc, cur, wr, wc, fr, fq); S.done(cur); }
        PG8_STAMP();
        if (!has_next) break;
#pragma unroll
        for (int a = 0; a < 2; ++a)
#pragma unroll
            for (int b = 0; b < 2; ++b)
#pragma unroll
                for (int m = 0; m < 4; ++m)
#pragma unroll
                    for (int n = 0; n < 2; ++n) acc[a][b][m][n] = (f32x4){0.f, 0.f, 0.f, 0.f};
        cur = nxt; cA = nA; cB = nB; ++ui;
    }
    PG8_WAIT_V(0);
    if (wr == 0) PG8_BAR;
    PG8_BAR;
    if constexpr (Epi::AFTER_DRAIN) { E.fused(acc, cur, wr, wc, fr, fq, lds, wid, lane); S.done(cur); }
    PG8_STAMP();
    if (STAMP && wid == 0) { stamps[lane] = lane < nts ? (((unsigned long long)(unsigned)ts_hi << 32) | (unsigned)ts_lo) : 0ull;
        if (lane == 62) stamps[62] = rt_entry; if (lane == 63) stamps[63] = (unsigned long long)wall_clock64(); }
#undef PG8_STAMP
#undef PG8_SA
#undef PG8_SB
#undef PG8_STAGE
#undef PG8_LDA
#undef PG8_LDB
#undef PG8_MMA
#undef PG8_WAIT_V
#undef PG8_WAIT_L
#undef PG8_BAR
#undef PG8_SCHED
}
}

#define LAS __attribute__((address_space(3)))
typedef unsigned short bf16_t;
typedef short bf16x8 __attribute__((ext_vector_type(8)));
typedef short s16x4 __attribute__((ext_vector_type(4)));
typedef float f32x4 __attribute__((ext_vector_type(4)));
typedef float f32x16 __attribute__((ext_vector_type(16)));
typedef unsigned u32x4 __attribute__((ext_vector_type(4)));
typedef unsigned u32x2 __attribute__((ext_vector_type(2)));
using pg8::cvt_pk_bf16;

constexpr int MT = 32768, SEQ = 4096, DM = 1024, DFF = 2816;
constexpr float EPS = 1e-6f;
constexpr size_t UU = 67108864ull;
constexpr size_t EW1GU = 0, EW1D = 5767168, EWIN = 8650752, EWG = 13631488, EWUQ = 14155776, EWUKV = 14745600, EWLO = 15269888,
                 EWMO = 16318464, EWO = 17367040, EW2GU = 18415616, EW2D = 24182784, EWPG = 27066368, EWPP = 28114944;
constexpr size_t OFF_INVF = 55ull << 20;
constexpr size_t OFF_RS = (55ull << 20) + (600ull << 10);
constexpr size_t OFF_BAR = (55ull << 20) + (512ull << 10);
constexpr size_t OFF_CARP = 56ull << 20, OFF_CARH = 60ull << 20;
constexpr size_t OFF_A = UU, OFF_B = 2 * UU, OFF_C = 3 * UU, OFF_D = 4 * UU, OFF_E = 5 * UU, OFF_F = 6 * UU, OFF_G = 6 * UU + UU / 2, OFF_H = 6 * UU + 3 * UU / 4;
constexpr size_t OFF_CQN = OFF_H, OFF_CKVN = OFF_CQN + 3 * UU / 8, OFF_KPE = OFF_CKVN + UU / 4, OFF_QR = OFF_KPE + UU / 16;
constexpr size_t WS_NEED = 8 * UU;
static_assert(OFF_QR + UU / 2 <= WS_NEED, "workspace map");
constexpr int LDS_BYTES = 152576;
constexpr int NPHASE = 18;

struct Params {
    const float *x, *p; const int* pos;
    const float *ffn1_norm, *ffn1_wg, *ffn1_wu, *ffn1_wd, *mix_norm, *w_in, *conv_w, *conv_b, *lru_wr, *lru_br, *lru_wi, *lru_bi, *lru_lam, *w_lru_out,
        *q_norm, *w_uq, *kv_norm, *w_ukv, *w_mla_out, *w_o, *ffn2_norm, *ffn2_wg, *ffn2_wu, *ffn2_wd, *ple_norm, *ple_wg, *ple_wp, *ple_pn, *final_norm;
    float* out; unsigned char* ws;
    float inv_freq[32];
};

__device__ __forceinline__ float bflo(unsigned w) { return __uint_as_float(w << 16); }
__device__ __forceinline__ float bfhi(unsigned w) { return __uint_as_float(w & 0xffff0000u); }
__device__ __forceinline__ float bf2f(bf16_t b) { return __uint_as_float(((unsigned)b) << 16); }
__device__ __forceinline__ bf16_t f2bf(float f) { return (bf16_t)(cvt_pk_bf16(f, f) & 0xffffu); }
__device__ __forceinline__ float fsigmoid(float x) { return __builtin_amdgcn_rcpf(1.0f + __expf(-x)); }
__device__ __forceinline__ float fsilu(float x) { return x * fsigmoid(x); }
__device__ __forceinline__ float fgelu_tanh(float x) { return x * fsigmoid(1.5957691216057308f * (x + 0.044715f * x * x * x)); }
__device__ __forceinline__ float wave_sum(float v, int lane) {
#pragma unroll
    for (int o = 32; o >= 1; o >>= 1) v += __uint_as_float((unsigned)__builtin_amdgcn_ds_bpermute((lane ^ o) << 2, (int)__float_as_uint(v)));
    return v;
}
__device__ __forceinline__ void rope_cs(float ang, float& c, float& s) {
    const float k = rintf(ang * 0.15915494309189535f);
    float r = fmaf(-k, 6.28318548202514648f, ang); r = fmaf(-k, -1.74845553e-07f, r);
    const float rev = r * 0.15915494309189535f;
    s = __builtin_amdgcn_sinf(rev); c = __builtin_amdgcn_cosf(rev);
}
__device__ __forceinline__ u32x4 pack8(const float (&e)[8]) { u32x4 w; w.x = cvt_pk_bf16(e[0], e[1]); w.y = cvt_pk_bf16(e[2], e[3]); w.z = cvt_pk_bf16(e[4], e[5]); w.w = cvt_pk_bf16(e[6], e[7]); return w; }
__device__ __forceinline__ void unpack8(u32x4 w, float (&e)[8]) { e[0] = bflo(w.x); e[1] = bfhi(w.x); e[2] = bflo(w.y); e[3] = bfhi(w.y); e[4] = bflo(w.z); e[5] = bfhi(w.z); e[6] = bflo(w.w); e[7] = bfhi(w.w); }

struct WtCtx { LAS float* tile; int gw, nw, lane, base; };
__device__ __forceinline__ void wt_job(WtCtx& c, const float* __restrict__ src, int K, int ldn, int n0, int ncols, bf16_t* __restrict__ dst, int ldd, int drow0, int grp, int gstride, const float* __restrict__ kscale = nullptr) {
    const int tk = K >> 6, tn = ncols >> 5, nt = tk * tn;
    int t = c.gw - c.base; if (t < 0) t += c.nw;
    const int rr = c.lane >> 3, c4 = (c.lane & 7) << 2, ks = c.lane & 7, nn = c.lane >> 3;
    for (; t < nt; t += c.nw) {
        const int nti = t % tn, kti = t / tn, k0 = kti << 6, j0 = nti << 5;
        float4 v[8];
#pragma unroll
        for (int i = 0; i < 8; ++i) v[i] = *(const float4*)(src + (size_t)(k0 + rr + 8 * i) * ldn + n0 + j0 + c4);
#pragma unroll
        for (int i = 0; i < 8; ++i) { LAS float* q = c.tile + (rr + 8 * i) * 33 + c4; q[0] = v[i].x; q[1] = v[i].y; q[2] = v[i].z; q[3] = v[i].w; }
        asm volatile("s_waitcnt lgkmcnt(0)" ::: "memory");
#pragma unroll
        for (int ps = 0; ps < 4; ++ps) {
            const int n = ps * 8 + nn;
            float e[8];
#pragma unroll
            for (int i = 0; i < 8; ++i) e[i] = c.tile[(ks * 8 + i) * 33 + n];
            if (kscale) {
#pragma unroll
                for (int i = 0; i < 8; ++i) e[i] *= kscale[k0 + ks * 8 + i]; }
            const int j = j0 + n, drow = drow0 + (j / grp) * gstride + (j % grp);
            *(u32x4*)(dst + (size_t)drow * ldd + k0 + ks * 8) = pack8(e);
        }
        asm volatile("s_waitcnt lgkmcnt(0)" ::: "memory");
    }
    c.base = (c.base + nt) % c.nw;
}

__device__ __forceinline__ void norm_rows(const float* in, const float* __restrict__ g, bf16_t* __restrict__ out, int gw, int nw, int lane) {
    float4 gv[4];
#pragma unroll
    for (int i = 0; i < 4; ++i) gv[i] = ((const float4*)g)[lane + 64 * i];
    for (int row = gw; row < MT; row += 2 * nw) {
        const int row2 = row + nw; const bool has2 = row2 < MT;
        const float4* p = (const float4*)(in + (size_t)row * DM); const float4* p2 = (const float4*)(in + (size_t)(has2 ? row2 : row) * DM);
        float4 v[4], w2[4];
#pragma unroll
        for (int i = 0; i < 4; ++i) { v[i] = p[lane + 64 * i]; w2[i] = p2[lane + 64 * i]; }
        float ss = 0.f, s2 = 0.f;
#pragma unroll
        for (int i = 0; i < 4; ++i) { ss += v[i].x * v[i].x + v[i].y * v[i].y + v[i].z * v[i].z + v[i].w * v[i].w; s2 += w2[i].x * w2[i].x + w2[i].y * w2[i].y + w2[i].z * w2[i].z + w2[i].w * w2[i].w; }
        ss = wave_sum(ss, lane); s2 = wave_sum(s2, lane);
        const float rs = rsqrtf(ss * (1.0f / 1024.0f) + EPS), rs2 = rsqrtf(s2 * (1.0f / 1024.0f) + EPS);
#pragma unroll
        for (int i = 0; i < 4; ++i) {
            u32x2 w; w.x = cvt_pk_bf16(v[i].x * rs * gv[i].x, v[i].y * rs * gv[i].y); w.y = cvt_pk_bf16(v[i].z * rs * gv[i].z, v[i].w * rs * gv[i].w);
            *(u32x2*)(out + (size_t)row * DM + 4 * (lane + 64 * i)) = w;
            if (has2) { u32x2 y; y.x = cvt_pk_bf16(w2[i].x * rs2 * gv[i].x, w2[i].y * rs2 * gv[i].y); y.y = cvt_pk_bf16(w2[i].z * rs2 * gv[i].z, w2[i].w * rs2 * gv[i].w);
                *(u32x2*)(out + (size_t)row2 * DM + 4 * (lane + 64 * i)) = y; }
        }
    }
}

__device__ __forceinline__ void mid_rows(const Params& p, int gw, int nw, int lane) {
    const bf16_t* cqkr = (const bf16_t*)(p.ws + OFF_F); const bf16_t* ckv = (const bf16_t*)(p.ws + OFF_G);
    bf16_t* cqn = (bf16_t*)(p.ws + OFF_CQN); bf16_t* ckvn = (bf16_t*)(p.ws + OFF_CKVN); bf16_t* kpe = (bf16_t*)(p.ws + OFF_KPE);
    const float* invf = (const float*)(p.ws + OFF_INVF);
    float2 gq[3], gk[2];
#pragma unroll
    for (int i = 0; i < 3; ++i) gq[i] = ((const float2*)p.q_norm)[lane + 64 * i];
#pragma unroll
    for (int i = 0; i < 2; ++i) gk[i] = ((const float2*)p.kv_norm)[lane + 64 * i];
    const float fi = invf[lane & 31];
    for (int row = gw; row < MT; row += nw) {
        const unsigned* q32 = (const unsigned*)(cqkr + (size_t)row * 512);
        const unsigned* k32 = (const unsigned*)(ckv + (size_t)row * 256);
        unsigned a[3], b[2];
#pragma unroll
        for (int i = 0; i < 3; ++i) a[i] = q32[lane + 64 * i];
#pragma unroll
        for (int i = 0; i < 2; ++i) b[i] = k32[lane + 64 * i];
        const float x1 = bf2f(cqkr[(size_t)row * 512 + 384 + (lane & 31)]), x2 = bf2f(cqkr[(size_t)row * 512 + 416 + (lane & 31)]);
        const float posf = (float)p.pos[row];
        float sq = 0.f, sk = 0.f;
#pragma unroll
        for (int i = 0; i < 3; ++i) { const float lo = bflo(a[i]), hi = bfhi(a[i]); sq += lo * lo + hi * hi; }
#pragma unroll
        for (int i = 0; i < 2; ++i) { const float lo = bflo(b[i]), hi = bfhi(b[i]); sk += lo * lo + hi * hi; }
        sq = wave_sum(sq, lane); sk = wave_sum(sk, lane);
        const float rq = rsqrtf(sq * (1.0f / 384.0f) + EPS), rk = rsqrtf(sk * (1.0f / 256.0f) + EPS);
        unsigned* oq = (unsigned*)(cqn + (size_t)row * 384); unsigned* ok = (unsigned*)(ckvn + (size_t)row * 256);
#pragma unroll
        for (int i = 0; i < 3; ++i) oq[lane + 64 * i] = cvt_pk_bf16(bflo(a[i]) * rq * gq[i].x, bfhi(a[i]) * rq * gq[i].y);
#pragma unroll
        for (int i = 0; i < 2; ++i) ok[lane + 64 * i] = cvt_pk_bf16(bflo(b[i]) * rk * gk[i].x, bfhi(b[i]) * rk * gk[i].y);
        float cs, sn; rope_cs(posf * fi, cs, sn);
        if (lane < 32) { kpe[(size_t)row * 64 + lane] = f2bf(x1 * cs - x2 * sn); kpe[(size_t)row * 64 + 32 + lane] = f2bf(x2 * cs + x1 * sn); }
    }
}

__device__ __forceinline__ void final_row_one(const Params& p, const float* gate, const float* pp, int row, int lane, const float4 (&g1)[4], const float4 (&g2)[4], const float4 (&h0)[4], const float4 (&g)[4], const float4 (&q)[4]) {
    float4 h[4];
    float s1 = 0.f;
#pragma unroll
    for (int i = 0; i < 4; ++i) { h[i] = h0[i]; s1 += q[i].x * q[i].x + q[i].y * q[i].y + q[i].z * q[i].z + q[i].w * q[i].w; }
    s1 = wave_sum(s1, lane);
    const float r1 = rsqrtf(s1 * (1.0f / 1024.0f) + EPS);
    float s2 = 0.f;
#pragma unroll
    for (int i = 0; i < 4; ++i) {
        h[i].x += g[i].x * (q[i].x * r1 * g1[i].x); h[i].y += g[i].y * (q[i].y * r1 * g1[i].y); h[i].z += g[i].z * (q[i].z * r1 * g1[i].z); h[i].w += g[i].w * (q[i].w * r1 * g1[i].w);
        s2 += h[i].x * h[i].x + h[i].y * h[i].y + h[i].z * h[i].z + h[i].w * h[i].w;
    }
    s2 = wave_sum(s2, lane);
    const float r2 = rsqrtf(s2 * (1.0f / 1024.0f) + EPS);
    float4* ph = (float4*)(p.out + (size_t)row * DM);
#pragma unroll
    for (int i = 0; i < 4; ++i) { float4 o; o.x = h[i].x * r2 * g2[i].x; o.y = h[i].y * r2 * g2[i].y; o.z = h[i].z * r2 * g2[i].z; o.w = h[i].w * r2 * g2[i].w; ph[lane + 64 * i] = o; }
}
__device__ __forceinline__ void final_rows(const Params& p, int gw, int nw, int lane) {
    const float* gate = (const float*)(p.ws + OFF_B); const float* pp = (const float*)(p.ws + OFF_D);
    float4 g1[4], g2[4];
#pragma unroll
    for (int i = 0; i < 4; ++i) { g1[i] = ((const float4*)p.ple_pn)[lane + 64 * i]; g2[i] = ((const float4*)p.final_norm)[lane + 64 * i]; }
    for (int row = gw; row < MT; row += 2 * nw) {
        const int row2 = row + nw; const bool has2 = row2 < MT; const int rb = has2 ? row2 : row;
        float4 ha[4], ga[4], qa[4], hb[4], gb[4], qb[4];
#pragma unroll
        for (int i = 0; i < 4; ++i) {
            ha[i] = ((const float4*)(p.out + (size_t)row * DM))[lane + 64 * i]; ga[i] = ((const float4*)(gate + (size_t)row * DM))[lane + 64 * i]; qa[i] = ((const float4*)(pp + (size_t)row * DM))[lane + 64 * i];
            hb[i] = ((const float4*)(p.out + (size_t)rb * DM))[lane + 64 * i]; gb[i] = ((const float4*)(gate + (size_t)rb * DM))[lane + 64 * i]; qb[i] = ((const float4*)(pp + (size_t)rb * DM))[lane + 64 * i];
        }
        final_row_one(p, gate, pp, row, lane, g1, g2, ha, ga, qa);
        if (has2) final_row_one(p, gate, pp, row2, lane, g1, g2, hb, gb, qb);
    }
}

template <int ACT> __device__ __forceinline__ void store_bf16_tile(const f32x4 (&acc)[2][2][4][2], bf16_t* O, int ld, int row0, int col0, const float* rs = nullptr) {
#pragma unroll
    for (int ai = 0; ai < 2; ++ai)
#pragma unroll
        for (int m = 0; m < 4; ++m) {
            bf16_t* rowp = O + (size_t)(row0 + ai * 128 + m * 16) * ld + col0;
            const float sc = rs ? rsqrtf(rs[row0 + ai * 128 + m * 16] * (1.0f / 1024.0f) + EPS) : 1.0f;
#pragma unroll
            for (int bj = 0; bj < 2; ++bj) {
                float e[8];
#pragma unroll
                for (int j = 0; j < 4; ++j) { e[j] = acc[ai][bj][m][0][j] * sc; e[4 + j] = acc[ai][bj][m][1][j] * sc; }
                if (ACT == 1) {
#pragma unroll
                    for (int j = 0; j < 8; ++j) e[j] = fgelu_tanh(e[j]);
                }
                if (ACT == 2) {
#pragma unroll
                    for (int j = 0; j < 8; ++j) e[j] = fsigmoid(e[j]);
                }
                *(u32x4*)(rowp + bj * 128) = pack8(e);
            }
        }
}
struct EpiSwiGLU {
    static constexpr bool PERM = true, AFTER_DRAIN = false; bf16_t* O; const float* rs;
    __device__ __forceinline__ void operator()(const f32x4 (&acc)[2][2][4][2], const pg8::Unit& u, int wr, int wc, int fr, int fq) const {
        const int row0 = u.pm * 256 + wr * 64 + fr, col0 = u.pn * 128 + wc * 32 + 8 * fq;
#pragma unroll
        for (int ai = 0; ai < 2; ++ai)
#pragma unroll
            for (int m = 0; m < 4; ++m) {
                const float sc = rs ? rsqrtf(rs[row0 + ai * 128 + m * 16] * (1.0f / 1024.0f) + EPS) : 1.0f;
                float e[8];
#pragma unroll
                for (int j = 0; j < 4; ++j) { e[j] = fsilu(acc[ai][0][m][0][j] * sc) * (acc[ai][1][m][0][j] * sc); e[4 + j] = fsilu(acc[ai][0][m][1][j] * sc) * (acc[ai][1][m][1][j] * sc); }
                *(u32x4*)(O + (size_t)(row0 + ai * 128 + m * 16) * DFF + col0) = pack8(e);
            }
    }
};
struct EpiResid {
    static constexpr bool PERM = false, AFTER_DRAIN = false; const float* base; float* out; bf16_t* hb; float* rs; float alpha; float pad_;
    __device__ __forceinline__ void operator()(const f32x4 (&acc)[2][2][4][2], const pg8::Unit& u, int wr, int wc, int fr, int fq) const {
        const int row0 = u.pm * 256 + wr * 64 + fr, col0 = u.pn * 256 + wc * 32 + 4 * fq;
#pragma unroll
        for (int ai = 0; ai < 2; ++ai)
#pragma unroll
            for (int m = 0; m < 4; ++m) {
                const size_t off = (size_t)(row0 + ai * 128 + m * 16) * DM + col0;
                float ssq = 0.f;
#pragma unroll
                for (int bj = 0; bj < 2; ++bj)
#pragma unroll
                    for (int n = 0; n < 2; ++n) { const f32x4 b = *(const f32x4*)(base + off + bj * 128 + n * 16); const f32x4 h = b + alpha * acc[ai][bj][m][n]; *(f32x4*)(out + off + bj * 128 + n * 16) = h;
                        if (hb) { u32x2 w; w.x = cvt_pk_bf16(h[0], h[1]); w.y = cvt_pk_bf16(h[2], h[3]); *(u32x2*)(hb + off + bj * 128 + n * 16) = w; ssq += h[0] * h[0] + h[1] * h[1] + h[2] * h[2] + h[3] * h[3]; } }
                if (hb) { ssq += __shfl_xor(ssq, 16); ssq += __shfl_xor(ssq, 32); if (fq == 0) (void)__hip_atomic_fetch_add(rs + row0 + ai * 128 + m * 16, ssq, __ATOMIC_RELAXED, __HIP_MEMORY_SCOPE_AGENT); }
            }
    }
};
template <int ACT> struct EpiF32Act {
    static constexpr bool PERM = false, AFTER_DRAIN = false; float* out; const float* rs;
    __device__ __forceinline__ void operator()(const f32x4 (&acc)[2][2][4][2], const pg8::Unit& u, int wr, int wc, int fr, int fq) const {
        const int row0 = u.pm * 256 + wr * 64 + fr, col0 = u.pn * 256 + wc * 32 + 4 * fq;
#pragma unroll
        for (int ai = 0; ai < 2; ++ai)
#pragma unroll
            for (int m = 0; m < 4; ++m) {
                const size_t off = (size_t)(row0 + ai * 128 + m * 16) * DM + col0;
                const float sc = rs ? rsqrtf(rs[row0 + ai * 128 + m * 16] * (1.0f / 1024.0f) + EPS) : 1.0f;
#pragma unroll
                for (int bj = 0; bj < 2; ++bj)
#pragma unroll
                    for (int n = 0; n < 2; ++n) { f32x4 v = acc[ai][bj][m][n] * sc;
                        if (ACT == 1) { v[0] = fsigmoid(v[0]); v[1] = fsigmoid(v[1]); v[2] = fsigmoid(v[2]); v[3] = fsigmoid(v[3]); }
                        *(f32x4*)(out + off + bj * 128 + n * 16) = v; }
            }
    }
};
struct EpiWin {
    static constexpr bool PERM = true, AFTER_DRAIN = false; unsigned char* ws; const float* rs;
    __device__ __forceinline__ void operator()(const f32x4 (&acc)[2][2][4][2], const pg8::Unit& u, int wr, int wc, int fr, int fq) const {
        const int pn = u.pn, row0 = u.pm * 256 + wr * 64 + fr, cw = wc * 32 + 8 * fq;
        if (pn < 4) store_bf16_tile<0>(acc, (bf16_t*)(ws + OFF_B), 1024, row0, 256 * pn + cw, rs);
        else if (pn < 8) store_bf16_tile<1>(acc, (bf16_t*)(ws + OFF_C), 1024, row0, 256 * (pn - 4) + cw, rs);
        else if (pn < 11) { bf16_t* O = (bf16_t*)(ws + (pn == 8 ? OFF_G : OFF_F)); const int ld = pn == 8 ? 256 : 512, c0 = pn == 8 ? 0 : 256 * (pn - 9); store_bf16_tile<0>(acc, O, ld, row0, c0 + cw, rs); }
        else { bf16_t* O = (bf16_t*)(ws + (pn < 15 ? OFF_D : OFF_E)); const int c0 = 256 * (pn < 15 ? pn - 11 : pn - 15); store_bf16_tile<2>(acc, O, 1024, row0, c0 + cw, rs); }
    }
};
struct EpiGateMul {
    static constexpr bool PERM = true, AFTER_DRAIN = false; const bf16_t* G; const bf16_t* T; bf16_t* O; int add;
    __device__ __forceinline__ void operator()(const f32x4 (&acc)[2][2][4][2], const pg8::Unit& u, int wr, int wc, int fr, int fq) const {
        const int row0 = u.pm * 256 + wr * 64 + fr, col0 = u.pn * 256 + wc * 32 + 8 * fq;
#pragma unroll
        for (int ai = 0; ai < 2; ++ai)
#pragma unroll
            for (int m = 0; m < 4; ++m) {
                const size_t off = (size_t)(row0 + ai * 128 + m * 16) * DM + col0;
#pragma unroll
                for (int bj = 0; bj < 2; ++bj) {
                    float g[8], e[8]; unpack8(*(const u32x4*)(G + off + bj * 128), g);
#pragma unroll
                    for (int j = 0; j < 4; ++j) { e[j] = g[j] * acc[ai][bj][m][0][j]; e[4 + j] = g[4 + j] * acc[ai][bj][m][1][j]; }
                    if (add) { float t[8]; unpack8(*(const u32x4*)(T + off + bj * 128), t);
#pragma unroll
                        for (int j = 0; j < 8; ++j) e[j] += t[j]; }
                    *(u32x4*)(O + off + bj * 128) = pack8(e);
                }
            }
    }
};
struct EpiQ {
    static constexpr bool PERM = true, AFTER_DRAIN = false; bf16_t* Qn; bf16_t* Qr;
    __device__ __forceinline__ void operator()(const f32x4 (&acc)[2][2][4][2], const pg8::Unit& u, int wr, int wc, int fr, int fq) const {
        const int row0 = u.pm * 256 + wr * 64 + fr;
        if (u.pn < 4) { store_bf16_tile<0>(acc, Qn, 1024, row0, 256 * u.pn + wc * 32 + 8 * fq); return; }
        const int head = 4 * (u.pn - 4) + wc;
#pragma unroll
        for (int ai = 0; ai < 2; ++ai)
#pragma unroll
            for (int m = 0; m < 4; ++m) {
                bf16_t* dst = Qr + (size_t)(row0 + ai * 128 + m * 16) * 512 + 64 * head + 8 * fq;
                float e[8];
#pragma unroll
                for (int j = 0; j < 4; ++j) { e[j] = acc[ai][0][m][0][j]; e[4 + j] = acc[ai][0][m][1][j]; }
                *(u32x4*)dst = pack8(e);
#pragma unroll
                for (int j = 0; j < 4; ++j) { e[j] = acc[ai][1][m][0][j]; e[4 + j] = acc[ai][1][m][1][j]; }
                *(u32x4*)(dst + 32) = pack8(e);
            }
    }
};
struct EpiKV {
    static constexpr bool PERM = true, AFTER_DRAIN = false; bf16_t* Kn; bf16_t* V;
    __device__ __forceinline__ void operator()(const f32x4 (&acc)[2][2][4][2], const pg8::Unit& u, int wr, int wc, int fr, int fq) const {
        const int row0 = u.pm * 256 + wr * 64 + fr, col0 = u.pn * 128 + wc * 32 + 8 * fq;
#pragma unroll
        for (int ai = 0; ai < 2; ++ai)
#pragma unroll
            for (int m = 0; m < 4; ++m) {
                const size_t off = (size_t)(row0 + ai * 128 + m * 16) * DM + col0;
                float e[8];
#pragma unroll
                for (int j = 0; j < 4; ++j) { e[j] = acc[ai][0][m][0][j]; e[4 + j] = acc[ai][0][m][1][j]; }
                *(u32x4*)(Kn + off) = pack8(e);
#pragma unroll
                for (int j = 0; j < 4; ++j) { e[j] = acc[ai][1][m][0][j]; e[4 + j] = acc[ai][1][m][1][j]; }
                *(u32x4*)(V + off) = pack8(e);
            }
    }
};

constexpr int LRU_XS = 272;
constexpr int LRU_AP = 132;
template <bool FINAL>
__device__ __forceinline__ void lru_phase(const Params& p, LAS unsigned char* lds, int bid, int G) {
    int tid_ = threadIdx.x; asm volatile("" : "+v"(tid_));
    const int tid = tid_, wid = tid >> 6, lane = tid & 63, fr = lane & 15, fq = lane >> 4;
    LAS unsigned char* Xs = lds;
    LAS float* AF = (LAS float*)(lds + 64 * LRU_XS);
    LAS float* UF = AF + 64 * LRU_AP; LAS float* AB = UF + 64 * LRU_AP; LAS float* UB = AB + 64 * LRU_AP;
    const bf16_t* zx = (const bf16_t*)(p.ws + OFF_B); const bf16_t* zg = (const bf16_t*)(p.ws + OFF_C); bf16_t* yA = (bf16_t*)(p.ws + OFF_A);
    float* carP = (float*)(p.ws + OFF_CARP); float* carH = (float*)(p.ws + OFF_CARH);
    const bf16_t* WG = (const bf16_t*)p.ws + EWG;
    bf16x8 Bf[4][4]; float brf = 0.f, bif = 0.f, brb = 0.f, bib = 0.f, spf = 0.f, spb = 0.f; int blk_have = -1;
    for (int item = bid; item < 4096; item += G) {
        const int blk = item & 7, c = (item >> 3) & 63, b = item >> 9;
        const int t0 = c * 64; const size_t rowbase = (size_t)b * SEQ;
        if (blk != blk_have) {
            blk_have = blk;
            const bf16_t* wb = WG + (size_t)blk * 65536 + (size_t)(wid * 16 + fr) * 128 + fq * 8;
#pragma unroll
            for (int g = 0; g < 4; ++g)
#pragma unroll
                for (int ks = 0; ks < 4; ++ks) Bf[g][ks] = *(const bf16x8*)(wb + (size_t)g * 16384 + ks * 32);
            const int cgc = blk * 128 + wid * 16 + fr;
            brf = p.lru_br[cgc]; bif = p.lru_bi[cgc]; brb = p.lru_br[1024 + cgc]; bib = p.lru_bi[1024 + cgc];
            spf = 8.0f * log1pf(expf(-p.lru_lam[cgc])); spb = 8.0f * log1pf(expf(-p.lru_lam[1024 + cgc]));
        }
        float hin = 0.f;
        if (FINAL) {
            for (int i = tid; i < 4096; i += 512) {
                const int d = i >> 11, cc = (i >> 5) & 63, q4 = i & 31;
                const size_t gofs = ((size_t)(b * 2 + d) * 64 + cc) * 1024 + blk * 128 + q4 * 4;
                const f32x4 pv = *(const f32x4*)(carP + gofs), hv = *(const f32x4*)(carH + gofs);
                *(LAS f32x4*)((d ? AB : AF) + cc * LRU_AP + q4 * 4) = pv; *(LAS f32x4*)((d ? UB : UF) + cc * LRU_AP + q4 * 4) = hv;
            }
            __syncthreads();
            if (tid < 256) {
                const int dir = tid >> 7, ch = tid & 127;
                const LAS float* Pp = dir ? AB : AF; const LAS float* Hh = dir ? UB : UF;
                if (dir == 0) {
#pragma unroll 16
                    for (int c2 = 0; c2 < 64; ++c2) { const float pv = Pp[c2 * LRU_AP + ch], hv = Hh[c2 * LRU_AP + ch]; hin = (c2 < c) ? pv * hin + hv : hin; }
                } else {
#pragma unroll 16
                    for (int c2 = 63; c2 >= 0; --c2) { const float pv = Pp[c2 * LRU_AP + ch], hv = Hh[c2 * LRU_AP + ch]; hin = (c2 > c) ? pv * hin + hv : hin; }
                }
            }
            __syncthreads();
        }
        { const int tok = tid >> 3, cs = tid & 7, cg0 = blk * 128 + cs * 16;
          float y[16];
#pragma unroll
          for (int q = 0; q < 4; ++q) { const float4 bv = *(const float4*)(p.conv_b + cg0 + 4 * q); y[4 * q] = bv.x; y[4 * q + 1] = bv.y; y[4 * q + 2] = bv.z; y[4 * q + 3] = bv.w; }
#pragma unroll
          for (int k = 0; k < 4; ++k) {
              const int t = t0 + tok + k - 2;
              if (t >= 0 && t < SEQ) {
                  const u32x4* zp = (const u32x4*)(zx + (rowbase + t) * DM + cg0);
                  float z[16]; { float e[8]; unpack8(zp[0], e);
#pragma unroll
                      for (int j = 0; j < 8; ++j) z[j] = e[j];
                      unpack8(zp[1], e);
#pragma unroll
                      for (int j = 0; j < 8; ++j) z[8 + j] = e[j]; }
#pragma unroll
                  for (int q = 0; q < 4; ++q) { const float4 wv = *(const float4*)(p.conv_w + k * 1024 + cg0 + 4 * q);
                      y[4 * q] += wv.x * z[4 * q]; y[4 * q + 1] += wv.y * z[4 * q + 1]; y[4 * q + 2] += wv.z * z[4 * q + 2]; y[4 * q + 3] += wv.w * z[4 * q + 3]; }
              }
          }
          float e0[8], e1[8];
#pragma unroll
          for (int j = 0; j < 8; ++j) { e0[j] = y[j]; e1[j] = y[8 + j]; }
          LAS u32x4* xd = (LAS u32x4*)(Xs + tok * LRU_XS + cs * 32);
          xd[0] = pack8(e0); xd[1] = pack8(e1);
        }
        __syncthreads();
        { const int ch = wid * 16 + fr;
#pragma unroll
          for (int m = 0; m < 4; ++m) {
              bf16x8 Af[4];
#pragma unroll
              for (int ks = 0; ks < 4; ++ks) Af[ks] = *(const LAS bf16x8*)(Xs + (16 * m + fr) * LRU_XS + (ks * 32 + fq * 8) * 2);
              f32x4 acc[4];
#pragma unroll
              for (int g = 0; g < 4; ++g) { acc[g] = (f32x4){0.f, 0.f, 0.f, 0.f};
#pragma unroll
                  for (int ks = 0; ks < 4; ++ks) acc[g] = __builtin_amdgcn_mfma_f32_16x16x32_bf16(Af[ks], Bf[g][ks], acc[g], 0, 0, 0); }
#pragma unroll
              for (int j = 0; j < 4; ++j) {
                  const int tok = 16 * m + 4 * fq + j;
                  const float x = bf2f(*(const LAS bf16_t*)(Xs + tok * LRU_XS + ch * 2));
#pragma unroll
                  for (int d = 0; d < 2; ++d) {
                      const float r = fsigmoid(acc[2 * d][j] + (d ? brb : brf)), gi = fsigmoid(acc[2 * d + 1][j] + (d ? bib : bif));
                      const float la = -r * (d ? spb : spf);
                      const float a = __expf(la);
                      const float e2 = 2.0f * la;
                      const float om = (e2 > -0.125f) ? -e2 * (1.0f + e2 * (0.5f + e2 * (0.16666667f + e2 * (0.041666668f + e2 * 0.0083333338f)))) : 1.0f - a * a;
                      const float uu = __builtin_amdgcn_sqrtf(om) * (gi * x);
                      (d ? AB : AF)[tok * LRU_AP + ch] = a; (d ? UB : UF)[tok * LRU_AP + ch] = uu;
                  }
              }
          }
        }
        __syncthreads();
        if (tid < 256) {
            const int dir = tid >> 7, ch = tid & 127, cgl = blk * 128 + ch;
            LAS float* Aa = dir ? AB : AF; LAS float* Uu = dir ? UB : UF;
            const size_t cb = ((size_t)(b * 2 + dir) * 64) * 1024 + cgl;
            float h = hin, P = 1.f;
            if (dir == 0) {
#pragma unroll 8
                for (int t = 0; t < 64; ++t) { const float a = Aa[t * LRU_AP + ch], uu = Uu[t * LRU_AP + ch]; h = a * h + uu; if (FINAL) Uu[t * LRU_AP + ch] = h; else P *= a; }
            } else {
#pragma unroll 8
                for (int t = 63; t >= 0; --t) { const float a = Aa[t * LRU_AP + ch], uu = Uu[t * LRU_AP + ch]; h = a * h + uu; if (FINAL) Uu[t * LRU_AP + ch] = h; else P *= a; }
            }
            if (!FINAL) { carP[cb + (size_t)c * 1024] = P; carH[cb + (size_t)c * 1024] = h; }
        }
        if (FINAL) {
            __syncthreads();
            const int tok = tid >> 3, cs = tid & 7, cg0 = blk * 128 + cs * 16; const size_t row = rowbase + t0 + tok;
            const u32x4* gp = (const u32x4*)(zg + row * DM + cg0);
            u32x4* yp = (u32x4*)(yA + row * DM + cg0);
#pragma unroll
            for (int hh = 0; hh < 2; ++hh) {
                float g[8], e[8]; unpack8(gp[hh], g);
                const f32x4 f0 = *(const LAS f32x4*)(UF + tok * LRU_AP + cs * 16 + hh * 8), f1 = *(const LAS f32x4*)(UF + tok * LRU_AP + cs * 16 + hh * 8 + 4);
                const f32x4 b0 = *(const LAS f32x4*)(UB + tok * LRU_AP + cs * 16 + hh * 8), b1 = *(const LAS f32x4*)(UB + tok * LRU_AP + cs * 16 + hh * 8 + 4);
#pragma unroll
                for (int j = 0; j < 4; ++j) { e[j] = (f0[j] + b0[j]) * g[j]; e[4 + j] = (f1[j] + b1[j]) * g[4 + j]; }
                yp[hh] = pack8(e);
            }
        }
    }
    __syncthreads();
}

namespace att {
constexpr int KVBLK = 64;
constexpr float SCALE = 0.07216878364870322f;
constexpr float THR = 8.f;
#ifndef ATT_SDEPTH
#define ATT_SDEPTH 1
#endif
constexpr int SDEPTH = ATT_SDEPTH;
constexpr int SHM_V = 64 * 128 * 2, SHM_K = 64 * 192 * 2;
#define ATT_KSWZ(row, colB) ((row) * 384 + ((colB) ^ (((row) & 7) << 4)))
#define ATT_SBAR() __builtin_amdgcn_sched_barrier(0)
__device__ __forceinline__ int crow(int r, int hi) { return (r & 3) + 8 * (r >> 2) + 4 * hi; }
__device__ __forceinline__ void partialSM(f32x16& p0, f32x16& p1, float& m_reg, float& mn, float& alpha) {
    constexpr float C = SCALE * 1.4426950408889634f;
    float pmax = p0[0];
#pragma unroll
    for (int r = 1; r < 16; ++r) pmax = fmaxf(pmax, p0[r]);
#pragma unroll
    for (int r = 0; r < 16; ++r) pmax = fmaxf(pmax, p1[r]);
    { auto rr = __builtin_amdgcn_permlane32_swap(__float_as_uint(pmax), __float_as_uint(pmax), false, false);
      pmax = fmaxf(__uint_as_float(rr[0]), __uint_as_float(rr[1])); }
    if (__builtin_expect(__all(pmax - m_reg <= THR / SCALE), 1)) { mn = m_reg; alpha = 1.f; }
    else { mn = fmaxf(m_reg, pmax); alpha = __builtin_amdgcn_exp2f((m_reg - mn) * C); m_reg = mn; }
    const float mnC = -mn * C;
#pragma unroll
    for (int r = 0; r < 16; ++r) p0[r] = fmaf(p0[r], C, mnC);
#pragma unroll
    for (int r = 0; r < 16; ++r) p1[r] = fmaf(p1[r], C, mnC);
#pragma unroll
    for (int r = 0; r < 16; ++r) p0[r] = __builtin_amdgcn_exp2f(p0[r]);
}
__device__ __forceinline__ void finishSM(f32x16& p0, f32x16& p1, float alpha, float& l_reg, bf16x8& pa0, bf16x8& pa1, bf16x8& pa2, bf16x8& pa3) {
#pragma unroll
    for (int r = 0; r < 16; ++r) p1[r] = __builtin_amdgcn_exp2f(p1[r]);
    float ps = 0;
#pragma unroll
    for (int r = 0; r < 16; ++r) ps += p0[r];
#pragma unroll
    for (int r = 0; r < 16; ++r) ps += p1[r];
    { auto rr = __builtin_amdgcn_permlane32_swap(__float_as_uint(ps), __float_as_uint(ps), false, false);
      ps = __uint_as_float(rr[0]) + __uint_as_float(rr[1]); }
    l_reg = l_reg * alpha + ps;
#define ATT_PK4(P, BASE, OUT) do { unsigned a0 = cvt_pk_bf16(P[BASE + 0], P[BASE + 1]), a1 = cvt_pk_bf16(P[BASE + 2], P[BASE + 3]);   \
    unsigned b0 = cvt_pk_bf16(P[BASE + 4], P[BASE + 5]), b1 = cvt_pk_bf16(P[BASE + 6], P[BASE + 7]);                              \
    auto r0 = __builtin_amdgcn_permlane32_swap(a0, b0, false, false); auto r1 = __builtin_amdgcn_permlane32_swap(a1, b1, false, false); \
    u32x4 w = {r0[0], r1[0], r0[1], r1[1]}; OUT = *reinterpret_cast<bf16x8*>(&w); } while (0)
    ATT_PK4(p0, 0, pa0); ATT_PK4(p0, 8, pa1); ATT_PK4(p1, 0, pa2); ATT_PK4(p1, 8, pa3);
#undef ATT_PK4
}
__device__ __forceinline__ void qkt(f32x16& p0, f32x16& p1, const char* Ks, const bf16x8* qr, int r32, int hi) {
    p0 = f32x16{}; p1 = f32x16{};
#pragma unroll
    for (int d0 = 0; d0 < 12; ++d0) { const int cb = (d0 * 16 + hi * 8) * 2;
        const bf16x8 b0 = *reinterpret_cast<const bf16x8*>(Ks + ATT_KSWZ(r32, cb));
        const bf16x8 b1 = *reinterpret_cast<const bf16x8*>(Ks + ATT_KSWZ(32 + r32, cb));
        p0 = __builtin_amdgcn_mfma_f32_32x32x16_bf16(b0, qr[d0], p0, 0, 0, 0);
        p1 = __builtin_amdgcn_mfma_f32_32x32x16_bf16(b1, qr[d0], p1, 0, 0, 0); }
}
__device__ __forceinline__ int v_st(int k, int c) { const int kk = (k & ~0xC) | ((k & 4) << 1) | ((k & 8) >> 1); return ((kk >> 3) * 4 + (c >> 5)) * 512 + ((kk & 7) * 32 + (c & 31)) * 2; }
__device__ __forceinline__ int v_rd_base(int lane) { return ((lane & 3) << 3) | (((lane >> 2) & 3) << 6) | (((lane >> 4) & 1) << 5) | (((lane >> 5) & 1) << 8); }
constexpr int v_rd_off(int d0, int ks, int half) { return d0 * 512 + ks * 4096 + half * 2048; }
template <int OFF> __device__ __forceinline__ s16x4 tr_read(int vb) {
    s16x4 r; asm volatile("ds_read_b64_tr_b16 %0, %1 offset:%2" : "=&v"(r) : "v"(vb), "i"(OFF) : "memory"); return r;
}
template <int D0> __device__ __forceinline__ void pv_one(f32x16& od, int vb, bf16x8 pa0, bf16x8 pa1, bf16x8 pa2, bf16x8 pa3) {
    const s16x4 l0 = tr_read<v_rd_off(D0, 0, 0)>(vb), h0 = tr_read<v_rd_off(D0, 0, 1)>(vb), l1 = tr_read<v_rd_off(D0, 1, 0)>(vb), h1 = tr_read<v_rd_off(D0, 1, 1)>(vb);
    const s16x4 l2 = tr_read<v_rd_off(D0, 2, 0)>(vb), h2 = tr_read<v_rd_off(D0, 2, 1)>(vb), l3 = tr_read<v_rd_off(D0, 3, 0)>(vb), h3 = tr_read<v_rd_off(D0, 3, 1)>(vb);
    asm volatile("s_waitcnt lgkmcnt(0)" ::: "memory"); ATT_SBAR();
#define ATT_PK(L, H) (bf16x8){L[0], L[1], L[2], L[3], H[0], H[1], H[2], H[3]}
    od = __builtin_amdgcn_mfma_f32_32x32x16_bf16(pa0, ATT_PK(l0, h0), od, 0, 0, 0);
    od = __builtin_amdgcn_mfma_f32_32x32x16_bf16(pa1, ATT_PK(l1, h1), od, 0, 0, 0);
    od = __builtin_amdgcn_mfma_f32_32x32x16_bf16(pa2, ATT_PK(l2, h2), od, 0, 0, 0);
    od = __builtin_amdgcn_mfma_f32_32x32x16_bf16(pa3, ATT_PK(l3, h3), od, 0, 0, 0);
#undef ATT_PK
}
__device__ __forceinline__ void pv_d0(f32x16* o, int vb, bf16x8 pa0, bf16x8 pa1, bf16x8 pa2, bf16x8 pa3) {
    pv_one<0>(o[0], vb, pa0, pa1, pa2, pa3); pv_one<1>(o[1], vb, pa0, pa1, pa2, pa3); pv_one<2>(o[2], vb, pa0, pa1, pa2, pa3); pv_one<3>(o[3], vb, pa0, pa1, pa2, pa3);
}
__device__ __forceinline__ void body(const bf16_t* Qn, const bf16_t* Qr, const bf16_t* __restrict__ Kh, const bf16_t* __restrict__ Vh, const bf16_t* __restrict__ Kp, bf16_t* Ob, const int* __restrict__ posq, const float* __restrict__ invf, char* lds) {
    int tid_ = threadIdx.x; asm volatile("" : "+v"(tid_));
    const int tid = tid_, wid = tid >> 6, lane = tid & 63, r32 = lane & 31, hi = lane >> 5;
    char* V_lds = lds; char* K_lds = lds + 2 * SHM_V;
    float* ws = (float*)(lds + 2 * SHM_V + 2 * SHM_K) + wid * 64; float* li_l = ws; float* al_l = ws + 32;
    float m_reg = -1e30f, l_reg = 0; f32x16 o[4] = {}; bf16x8 qr[12];
    { const bf16_t* qa = Qn + (size_t)(wid * 32 + r32) * 1024 + hi * 8; const bf16_t* qb = Qr + (size_t)(wid * 32 + r32) * 512 + hi * 8;
#pragma unroll
      for (int d0 = 0; d0 < 8; ++d0) qr[d0] = *reinterpret_cast<const bf16x8*>(qa + d0 * 16);
#pragma unroll
      for (int d0 = 0; d0 < 4; ++d0) qr[8 + d0] = *reinterpret_cast<const bf16x8*>(qb + d0 * 16); }
    {
        const float posf = (float)posq[wid * 32 + r32];
#pragma unroll
        for (int t = 0; t < 2; ++t) {
            const f32x4 fa = *(const f32x4*)(invf + 16 * t + 8 * hi), fb = *(const f32x4*)(invf + 16 * t + 8 * hi + 4);
            float x1[8], x2[8], o1[8], o2[8];
            unpack8(*reinterpret_cast<const u32x4*>(&qr[8 + t]), x1); unpack8(*reinterpret_cast<const u32x4*>(&qr[10 + t]), x2);
#pragma unroll
            for (int j = 0; j < 8; ++j) { float cs, sn; rope_cs(posf * (j < 4 ? fa[j] : fb[j - 4]), cs, sn); o1[j] = x1[j] * cs - x2[j] * sn; o2[j] = x2[j] * cs + x1[j] * sn; }
            const u32x4 w1 = pack8(o1), w2 = pack8(o2);
            qr[8 + t] = *reinterpret_cast<const bf16x8*>(&w1); qr[10 + t] = *reinterpret_cast<const bf16x8*>(&w2);
        }
    }
    const int sr = tid >> 4, sc = (tid & 15) * 8, vst0 = v_st(sr, sc), vst1 = v_st(32 + sr, sc);
    const int pr = tid >> 3, pc = (tid & 7) * 8;
    const int vb0 = (int)(uintptr_t)V_lds + v_rd_base(lane);
    struct { bf16x8 vs0, vs1, ks0, ks1, kp; } sr_[SDEPTH];
#define ATT_SLOAD(i, k0) do { sr_[i].vs0 = *(const bf16x8*)(&Vh[(size_t)((k0) + sr) * 1024 + sc]); sr_[i].vs1 = *(const bf16x8*)(&Vh[(size_t)((k0) + 32 + sr) * 1024 + sc]); \
    sr_[i].ks0 = *(const bf16x8*)(&Kh[(size_t)((k0) + sr) * 1024 + sc]); sr_[i].ks1 = *(const bf16x8*)(&Kh[(size_t)((k0) + 32 + sr) * 1024 + sc]); \
    sr_[i].kp = *(const bf16x8*)(&Kp[(size_t)((k0) + pr) * 64 + pc]); } while (0)
#define ATT_SWRITE(b, i) do { *(bf16x8*)(V_lds + (b) * SHM_V + vst0) = sr_[i].vs0; *(bf16x8*)(V_lds + (b) * SHM_V + vst1) = sr_[i].vs1; const int kc = sc * 2; \
    *(bf16x8*)(K_lds + (b) * SHM_K + ATT_KSWZ(sr, kc)) = sr_[i].ks0; *(bf16x8*)(K_lds + (b) * SHM_K + ATT_KSWZ(32 + sr, kc)) = sr_[i].ks1; \
    *(bf16x8*)(K_lds + (b) * SHM_K + ATT_KSWZ(pr, 256 + pc * 2)) = sr_[i].kp; } while (0)
#define ATT_SWAIT() do { if constexpr (SDEPTH == 2) asm volatile("s_waitcnt vmcnt(5)" ::: "memory"); else asm volatile("s_waitcnt vmcnt(0)" ::: "memory"); } while (0)
#define ATT_RESC(a) do { if (__any((a) < 1.f)) { if (hi == 0) al_l[r32] = (a); asm volatile("s_waitcnt lgkmcnt(0)" ::: "memory"); \
    _Pragma("unroll") for (int d = 0; d < 4; ++d) _Pragma("unroll") for (int r = 0; r < 16; ++r) o[d][r] *= al_l[crow(r, hi)]; } } while (0)
    f32x16 pA0, pA1, pB0, pB1; float mnA, mnB, alA, alB; bf16x8 pa0, pa1, pa2, pa3; constexpr int NT = SEQ / KVBLK;
    constexpr int SE = 0, SO = SDEPTH - 1;
    ATT_SLOAD(SE, 0); asm volatile("s_waitcnt vmcnt(0)" ::: "memory"); ATT_SWRITE(0, SE); __syncthreads();
    qkt(pA0, pA1, K_lds, qr, r32, hi); partialSM(pA0, pA1, m_reg, mnA, alA);
    ATT_SLOAD(SO, KVBLK); if constexpr (SDEPTH == 2) ATT_SLOAD(SE, 2 * KVBLK);
    ATT_SWAIT(); ATT_SWRITE(1, SO); __syncthreads();
    for (int j = 1; j + 1 < NT; j += 2) {
        ATT_SBAR(); qkt(pB0, pB1, K_lds + SHM_K, qr, r32, hi);
        finishSM(pA0, pA1, alA, l_reg, pa0, pa1, pa2, pa3); ATT_SBAR();
        ATT_SLOAD(SO, (j + SDEPTH) * KVBLK); ATT_SBAR();
        pv_d0(o, vb0, pa0, pa1, pa2, pa3); partialSM(pB0, pB1, m_reg, mnB, alB);
        __syncthreads(); ATT_SWAIT(); ATT_SWRITE(0, SE);
        ATT_RESC(alB); __syncthreads();
        ATT_SBAR(); qkt(pA0, pA1, K_lds, qr, r32, hi);
        finishSM(pB0, pB1, alB, l_reg, pa0, pa1, pa2, pa3); ATT_SBAR();
        if (SDEPTH == 1 || j + 3 < NT) ATT_SLOAD(SE, (j + 1 + SDEPTH) * KVBLK); ATT_SBAR();
        pv_d0(o, vb0 + SHM_V, pa0, pa1, pa2, pa3); partialSM(pA0, pA1, m_reg, mnA, alA);
        __syncthreads(); ATT_SWAIT(); ATT_SWRITE(1, SO);
        ATT_RESC(alA); __syncthreads();
    }
    ATT_SBAR(); qkt(pB0, pB1, K_lds + SHM_K, qr, r32, hi);
    finishSM(pA0, pA1, alA, l_reg, pa0, pa1, pa2, pa3); ATT_SBAR();
    pv_d0(o, vb0, pa0, pa1, pa2, pa3); partialSM(pB0, pB1, m_reg, mnB, alB);
    __syncthreads(); ATT_RESC(alB);
    finishSM(pB0, pB1, alB, l_reg, pa0, pa1, pa2, pa3); ATT_SBAR();
    pv_d0(o, vb0 + SHM_V, pa0, pa1, pa2, pa3);
    if (hi == 0) li_l[r32] = l_reg; asm volatile("s_waitcnt lgkmcnt(0)" ::: "memory");
    float rli[16];
#pragma unroll
    for (int r = 0; r < 16; ++r) rli[r] = __builtin_amdgcn_rcpf(li_l[crow(r, hi)]);
    bf16_t* Ow = Ob + (size_t)(wid * 32) * 1024;
#pragma unroll
    for (int r = 0; r < 16; ++r) { const int orow = crow(r, hi);
#pragma unroll
        for (int d0 = 0; d0 < 4; ++d0) Ow[(size_t)orow * 1024 + d0 * 32 + r32] = f2bf(o[d0][r] * rli[r]); }
#undef ATT_SLOAD
#undef ATT_SWRITE
#undef ATT_SWAIT
#undef ATT_RESC
}
}

__device__ __forceinline__ void attn_phase(const Params& p, char* smem, int bid, int G) {
    bf16_t* Qn = (bf16_t*)(p.ws + OFF_A); const bf16_t* Qr = (const bf16_t*)(p.ws + OFF_QR);
    const bf16_t* Kn = (const bf16_t*)(p.ws + OFF_C); const bf16_t* V = (const bf16_t*)(p.ws + OFF_D); const bf16_t* Kp = (const bf16_t*)(p.ws + OFF_KPE);
    for (int u = bid; u < 1024; u += G) {
        const int qb = u & 15, h = (u >> 4) & 7, b = u >> 7;
        const size_t r0 = (size_t)b * SEQ, q0 = r0 + (size_t)qb * 256;
        __syncthreads();
        att::body(Qn + q0 * 1024 + 128 * h, Qr + q0 * 512 + 64 * h, Kn + r0 * 1024 + 128 * h, V + r0 * 1024 + 128 * h, Kp + r0 * 64, Qn + q0 * 1024 + 128 * h, p.pos + q0, (const float*)(p.ws + OFF_INVF), smem);
    }
    __syncthreads();
}

__device__ __forceinline__ void phase_prep(const Params& p, LAS unsigned char* lds, int gw, int nw, int wid, int lane) {
    bf16_t* W = (bf16_t*)p.ws;
    WtCtx c{(LAS float*)(lds + wid * 8448), gw, nw, lane, 0};
#pragma unroll 1
    for (int f = 0; f < 2; ++f) {
        const float* wg = f ? p.ffn2_wg : p.ffn1_wg; const float* wu = f ? p.ffn2_wu : p.ffn1_wu; const float* wd = f ? p.ffn2_wd : p.ffn1_wd;
        bf16_t* gu = W + (f ? EW2GU : EW1GU); bf16_t* dn = W + (f ? EW2D : EW1D);
        const float* ks = f ? p.ffn2_norm : nullptr;
        wt_job(c, wg, 1024, 2816, 0, 2816, gu, 1024, 0, 128, 256, ks);
        wt_job(c, wu, 1024, 2816, 0, 2816, gu, 1024, 128, 128, 256, ks);
        wt_job(c, wd, 2816, 1024, 0, 1024, dn, 2816, 0, 1024, 0);
    }
    { bf16_t* Win = W + EWIN;
      wt_job(c, p.w_in, 1024, 4800, 0, 1024, Win, 1024, 0, 1024, 0, p.mix_norm);
      wt_job(c, p.w_in, 1024, 4800, 1024, 1024, Win, 1024, 1024, 1024, 0, p.mix_norm);
      wt_job(c, p.w_in, 1024, 4800, 2432, 256, Win, 1024, 2048, 256, 0, p.mix_norm);
      wt_job(c, p.w_in, 1024, 4800, 2048, 384, Win, 1024, 2304, 384, 0, p.mix_norm);
      wt_job(c, p.w_in, 1024, 4800, 2688, 64, Win, 1024, 2688, 64, 0, p.mix_norm);
      wt_job(c, p.w_in, 1024, 4800, 2752, 1024, Win, 1024, 2816, 1024, 0, p.mix_norm);
      wt_job(c, p.w_in, 1024, 4800, 3776, 1024, Win, 1024, 3840, 1024, 0, p.mix_norm);
      const int gt = gw * 64 + lane;
      for (int i = gt; i < 8192; i += nw * 64) ((u32x4*)(Win + 2752 * 1024))[i] = (u32x4){0u, 0u, 0u, 0u};
    }
#pragma unroll 1
    for (int db = 0; db < 16; ++db) {
        const int dir = db >> 3, blk = db & 7;
        wt_job(c, p.lru_wr + (size_t)db * 16384, 128, 128, 0, 128, W + EWG + (size_t)blk * 65536, 128, dir * 256, 128, 0);
        wt_job(c, p.lru_wi + (size_t)db * 16384, 128, 128, 0, 128, W + EWG + (size_t)blk * 65536, 128, dir * 256 + 128, 128, 0);
    }
#pragma unroll 1
    for (int h = 0; h < 8; ++h) {
        wt_job(c, p.w_uq, 384, 1536, 192 * h, 128, W + EWUQ, 384, 128 * h, 128, 0);
        wt_job(c, p.w_uq, 384, 1536, 192 * h + 128, 32, W + EWUQ, 384, 1024 + 256 * (h >> 2) + 32 * (h & 3), 32, 0);
        wt_job(c, p.w_uq, 384, 1536, 192 * h + 160, 32, W + EWUQ, 384, 1024 + 256 * (h >> 2) + 128 + 32 * (h & 3), 32, 0);
    }
    wt_job(c, p.w_ukv, 256, 2048, 0, 2048, W + EWUKV, 256, 0, 2048, 0);
    wt_job(c, p.w_lru_out, 1024, 1024, 0, 1024, W + EWLO, 1024, 0, 1024, 0);
    wt_job(c, p.w_mla_out, 1024, 1024, 0, 1024, W + EWMO, 1024, 0, 1024, 0);
    wt_job(c, p.w_o, 1024, 1024, 0, 1024, W + EWO, 1024, 0, 1024, 0);
    wt_job(c, p.ple_wg, 1024, 1024, 0, 1024, W + EWPG, 1024, 0, 1024, 0, p.ple_norm);
    wt_job(c, p.ple_wp, 256, 1024, 0, 1024, W + EWPP, 256, 0, 1024, 0);
    if (gw == 0 && lane == 0) { float* t = (float*)(p.ws + OFF_INVF);
#pragma unroll
        for (int i = 0; i < 32; ++i) t[i] = p.inv_freq[i]; }
    { float* rs = (float*)(p.ws + OFF_RS); for (int i = gw * 64 + lane; i < 3 * MT; i += nw * 64) rs[i] = 0.f; }
    norm_rows(p.x, p.ffn1_norm, (bf16_t*)(p.ws + OFF_A), gw, nw, lane);
}

template <class Epi> __device__ __forceinline__ void run_gemm(LAS unsigned char* lds, const bf16_t* A, const bf16_t* Bt, int N, int K, const Epi E, int bid, int G) {
    pg8::Gemm g{A, Bt, MT, N, K}; pg8::StaticOrder S; S.init(MT, N, G, bid);
    pg8::gemm_phase<Epi, pg8::StaticOrder, false>(lds, g, S, E, nullptr);
}

__device__ __forceinline__ void run_phase(const Params& p, int ph, unsigned char* smem) {
    LAS unsigned char* lds = (LAS unsigned char*)smem;
    int tid_ = threadIdx.x; asm volatile("" : "+v"(tid_));
    int bid = blockIdx.x, G = gridDim.x; asm volatile("" : "+s"(bid), "+s"(G));
    const int tid = tid_, wid = tid >> 6, lane = tid & 63, nw = G * 8, gw = bid * 8 + wid;
    unsigned char* ws = p.ws; const bf16_t* W = (const bf16_t*)ws;
    bf16_t* bA = (bf16_t*)(ws + OFF_A); bf16_t* bD = (bf16_t*)(ws + OFF_D);
#ifndef PH_MASK
#define PH_MASK 0x3ffff
#endif
#define PH_ON(k) constexpr (((PH_MASK) >> (k)) & 1)
    switch (ph) {
    case 0: if PH_ON(0) phase_prep(p, lds, gw, nw, wid, lane); break;
    case 1: case 13: if PH_ON(1) {
        if (ph == 13) { bf16_t* pb = (bf16_t*)(ws + OFF_F);
            for (int i = gw * 64 + lane; i < MT * 256 / 8; i += nw * 64) { const float4 a = ((const float4*)p.p)[2 * i], b = ((const float4*)p.p)[2 * i + 1];
                const float e[8] = {a.x, a.y, a.z, a.w, b.x, b.y, b.z, b.w}; ((u32x4*)pb)[i] = pack8(e); } }
        EpiSwiGLU E{(bf16_t*)(ws + OFF_B), ph == 13 ? (const float*)(ws + OFF_RS) + MT : nullptr}; run_gemm(lds, bA, W + (ph == 1 ? EW1GU : EW2GU), 5632, 1024, E, bid, G); } break;
    case 2: case 14: if PH_ON(2) { EpiResid E{ph == 2 ? p.x : p.out, p.out, bA, (float*)(ws + OFF_RS) + (ph == 2 ? 0 : 2 * MT), 0.5f, 0.f}; run_gemm(lds, (const bf16_t*)(ws + OFF_B), W + (ph == 2 ? EW1D : EW2D), 1024, 2816, E, bid, G); } break;
    case 3: if PH_ON(3) norm_rows(p.out, p.mix_norm, bA, gw, nw, lane); break;
    case 4: if PH_ON(4) { EpiWin E{ws, (const float*)(ws + OFF_RS)}; run_gemm(lds, bA, W + EWIN, 4864, 1024, E, bid, G); } break;
    case 5: if PH_ON(5) { lru_phase<false>(p, lds, bid, G); mid_rows(p, gw, nw, lane); } break;
    case 6: if PH_ON(6) lru_phase<true>(p, lds, bid, G); break;
    case 7: if PH_ON(7) { EpiGateMul E{bD, bD, (bf16_t*)(ws + OFF_B), 0}; run_gemm(lds, bA, W + EWLO, 1024, 1024, E, bid, G); } break;
    case 8: if PH_ON(8) { EpiQ Eq{bA, (bf16_t*)(ws + OFF_QR)}; run_gemm(lds, (const bf16_t*)(ws + OFF_CQN), W + EWUQ, 1536, 384, Eq, bid, G);
              EpiKV Ek{(bf16_t*)(ws + OFF_C), (bf16_t*)(ws + OFF_D)}; run_gemm(lds, (const bf16_t*)(ws + OFF_CKVN), W + EWUKV, 2048, 256, Ek, bid, G); } break;
    case 9: if PH_ON(9) attn_phase(p, (char*)smem, bid, G); break;
    case 10: if PH_ON(10) { EpiGateMul E{(const bf16_t*)(ws + OFF_E), (const bf16_t*)(ws + OFF_B), (bf16_t*)(ws + OFF_C), 1}; run_gemm(lds, bA, W + EWMO, 1024, 1024, E, bid, G); } break;
    case 11: if PH_ON(11) { EpiResid E{p.out, p.out, bA, (float*)(ws + OFF_RS) + MT, 1.0f, 0.f}; run_gemm(lds, (const bf16_t*)(ws + OFF_C), W + EWO, 1024, 1024, E, bid, G); } break;
    case 12: if PH_ON(12) norm_rows(p.out, p.ffn2_norm, bA, gw, nw, lane); break;
    case 15: if PH_ON(15) { norm_rows(p.out, p.ple_norm, bA, gw, nw, lane);
               bf16_t* pb = (bf16_t*)(ws + OFF_F);
               for (int i = gw * 64 + lane; i < MT * 256 / 8; i += nw * 64) { const float4 a = ((const float4*)p.p)[2 * i], b = ((const float4*)p.p)[2 * i + 1];
                   const float e[8] = {a.x, a.y, a.z, a.w, b.x, b.y, b.z, b.w}; ((u32x4*)pb)[i] = pack8(e); } } break;
    case 16: if PH_ON(16) { EpiF32Act<1> Eg{(float*)(ws + OFF_B), (const float*)(ws + OFF_RS) + 2 * MT}; run_gemm(lds, bA, W + EWPG, 1024, 1024, Eg, bid, G);
               EpiF32Act<0> Ep{(float*)(ws + OFF_D), nullptr}; run_gemm(lds, (const bf16_t*)(ws + OFF_F), W + EWPP, 1024, 256, Ep, bid, G); } break;
    case 17: if PH_ON(17) final_rows(p, gw, nw, lane); break;
    default: break;
    }
}

typedef const __attribute__((address_space(4))) Params* KP;
#if defined(__HIP_DEVICE_COMPILE__)
#define MK_PHASE(k) do { KP q = (KP)__builtin_amdgcn_kernarg_segment_ptr(); asm volatile("" : "+s"(q)); const Params lp = *q; run_phase(lp, (k), smem); } while (0)
#else
#define MK_PHASE(k) do { (void)smem; } while (0)
#endif
#if MK_ONE_LAUNCH
__device__ __forceinline__ void grid_bar(unsigned* ctr, unsigned target) {
    asm volatile("s_waitcnt vmcnt(0) lgkmcnt(0)" ::: "memory");
    __syncthreads();
    if (threadIdx.x == 0) {
        __builtin_amdgcn_fence(__ATOMIC_RELEASE, "agent");
        asm volatile("s_waitcnt vmcnt(0)" ::: "memory");
        __hip_atomic_fetch_add(ctr, 1u, __ATOMIC_RELAXED, __HIP_MEMORY_SCOPE_AGENT);
        while (__hip_atomic_load(ctr, __ATOMIC_RELAXED, __HIP_MEMORY_SCOPE_AGENT) < target) __builtin_amdgcn_s_sleep(1);
        __builtin_amdgcn_fence(__ATOMIC_ACQUIRE, "agent");
        asm volatile("s_waitcnt vmcnt(0)" ::: "memory");
    }
    __syncthreads();
}
__global__ void __launch_bounds__(512, 2) mk(Params p_unused) {
    extern __shared__ __attribute__((aligned(16))) unsigned char smem[];
    cg::grid_group grid = cg::this_grid();
    unsigned* ctr = nullptr; unsigned G = gridDim.x;
#if defined(__HIP_DEVICE_COMPILE__)
    { KP q = (KP)__builtin_amdgcn_kernarg_segment_ptr(); ctr = (unsigned*)(q->ws + OFF_BAR); }
#endif
    unsigned bt = 0;
#define GB(k) grid_bar(ctr, (bt += G))
    if (blockIdx.x == 0 && threadIdx.x == 0) __hip_atomic_store(ctr, 0u, __ATOMIC_RELAXED, __HIP_MEMORY_SCOPE_AGENT);
    grid.sync();
    MK_PHASE(0); GB(1); MK_PHASE(1); GB(2); MK_PHASE(2); GB(3); MK_PHASE(4); GB(5); MK_PHASE(5); GB(6);
    MK_PHASE(6); GB(7); MK_PHASE(7); GB(8); MK_PHASE(8); GB(9); MK_PHASE(9); GB(10); MK_PHASE(10); GB(11); MK_PHASE(11); GB(12);
    MK_PHASE(13); GB(14); MK_PHASE(14); GB(15); MK_PHASE(16); GB(17); MK_PHASE(17);
#undef GB
}
#else
template <int PH> __global__ void __launch_bounds__(512, 2) mkp(Params p_unused) {
    extern __shared__ __attribute__((aligned(16))) unsigned char smem[];
    MK_PHASE(PH);
}
template <int PH> static void launch_phases(const Params& p, int grid, hipStream_t stream, bool setattr) {
    if constexpr (PH < NPHASE) {
        if (setattr) { if (hipFuncSetAttribute((const void*)mkp<PH>, hipFuncAttributeMaxDynamicSharedMemorySize, LDS_BYTES) != hipSuccess) fprintf(stderr, "kernel_launch: hipFuncSetAttribute failed (phase %d)\n", PH); }
        else {
#if defined(MK_DEBUG)
            if (PH == 9) hipLaunchKernelGGL(chk, dim3(1), dim3(64), 0, stream, p, 89);
            if (PH == 7) hipLaunchKernelGGL(chk, dim3(1), dim3(64), 0, stream, p, 70);
            if (PH == 10) hipLaunchKernelGGL(chk, dim3(1), dim3(64), 0, stream, p, 90);
            if (PH == 11) hipLaunchKernelGGL(chk, dim3(1), dim3(64), 0, stream, p, 91);
            if (PH == 14) hipLaunchKernelGGL(chk, dim3(1), dim3(64), 0, stream, p, 92);
            if (PH == 17) hipLaunchKernelGGL(chk, dim3(1), dim3(64), 0, stream, p, 93);
#endif
            hipLaunchKernelGGL(mkp<PH>, dim3(grid), dim3(512), LDS_BYTES, stream, p);
#if defined(MK_DEBUG)
            if (true) hipLaunchKernelGGL(chk, dim3(1), dim3(64), 0, stream, p, PH);
            if (PH == NPHASE - 1) hipLaunchKernelGGL(chk, dim3(1), dim3(64), 0, stream, p, MK_DEBUG);
#endif
        }
        launch_phases<PH + 1>(p, grid, stream, setattr);
    }
}
#endif

extern "C" void kernel_launch(void* const* d_in, const int* in_sizes, int n_in, void* d_out, int out_size, void* d_ws, size_t ws_size, hipStream_t stream) {
    static int grid = 0;
    if (grid == 0) {
        if (n_in != 32 || in_sizes[0] != MT * DM || out_size != MT * DM || ws_size < WS_NEED) {
            fprintf(stderr, "kernel_launch: unexpected shapes: n_in %d in0 %d out %d ws %zu (need %zu)\n", n_in, n_in > 0 ? in_sizes[0] : -1, out_size, ws_size, (size_t)WS_NEED); grid = -1; return; }
        int dev = 0, cus = 0, per_cu = 0;
        (void)hipGetDevice(&dev); (void)hipDeviceGetAttribute(&cus, hipDeviceAttributeMultiprocessorCount, dev);
#if MK_ONE_LAUNCH
        if (hipFuncSetAttribute((const void*)mk, hipFuncAttributeMaxDynamicSharedMemorySize, LDS_BYTES) != hipSuccess) { fprintf(stderr, "kernel_launch: hipFuncSetAttribute failed\n"); grid = -1; return; }
        if (hipOccupancyMaxActiveBlocksPerMultiprocessor(&per_cu, (const void*)mk, 512, LDS_BYTES) != hipSuccess || per_cu < 1) { fprintf(stderr, "kernel_launch: occupancy query gives %d\n", per_cu); per_cu = 1; }
#else
        { Params z{}; launch_phases<0>(z, 0, stream, true); }
#endif
        (void)hipGetLastError();
        grid = cus;
    }
    if (grid < 0) return;
    Params p{};
    p.x = (const float*)d_in[0]; p.p = (const float*)d_in[1]; p.pos = (const int*)d_in[2];
    p.ffn1_norm = (const float*)d_in[3]; p.ffn1_wg = (const float*)d_in[4]; p.ffn1_wu = (const float*)d_in[5]; p.ffn1_wd = (const float*)d_in[6];
    p.mix_norm = (const float*)d_in[7]; p.w_in = (const float*)d_in[8]; p.conv_w = (const float*)d_in[9]; p.conv_b = (const float*)d_in[10];
    p.lru_wr = (const float*)d_in[11]; p.lru_br = (const float*)d_in[12]; p.lru_wi = (const float*)d_in[13]; p.lru_bi = (const float*)d_in[14]; p.lru_lam = (const float*)d_in[15];
    p.w_lru_out = (const float*)d_in[16]; p.q_norm = (const float*)d_in[17]; p.w_uq = (const float*)d_in[18]; p.kv_norm = (const float*)d_in[19]; p.w_ukv = (const float*)d_in[20];
    p.w_mla_out = (const float*)d_in[21]; p.w_o = (const float*)d_in[22]; p.ffn2_norm = (const float*)d_in[23]; p.ffn2_wg = (const float*)d_in[24]; p.ffn2_wu = (const float*)d_in[25];
    p.ffn2_wd = (const float*)d_in[26]; p.ple_norm = (const float*)d_in[27]; p.ple_wg = (const float*)d_in[28]; p.ple_wp = (const float*)d_in[29]; p.ple_pn = (const float*)d_in[30];
    p.final_norm = (const float*)d_in[31];
    p.out = (float*)d_out; p.ws = (unsigned char*)d_ws;
    for (int i = 0; i < 32; ++i) p.inv_freq[i] = (float)pow(10000.0, -(double)(2 * i) / 64.0);
#if MK_ONE_LAUNCH
    void* args[] = {&p};
    hipError_t e = hipLaunchCooperativeKernel((const void*)mk, dim3(grid), dim3(512), args, LDS_BYTES, stream);
    if (e != hipSuccess) fprintf(stderr, "kernel_launch: cooperative launch failed: %s (grid %d)\n", hipGetErrorString(e), grid);
#else
    launch_phases<0>(p, grid, stream, false);
    hipError_t e = hipPeekAtLastError();
    if (e != hipSuccess) fprintf(stderr, "kernel_launch: launch failed: %s\n", hipGetErrorString(e));
#endif
}
```
